# Optimizing an MI355X kernel written in HIP

```python
import jax, jax.numpy as jnp
from jax import lax
import numpy as np

D_MODEL = 1024
BATCH = 2
SEQ = 8192
DEPTH = 1

HG_HEADS = 4
HG_DIM = 128
HG_WIDTH = HG_HEADS * HG_DIM
HG_CHUNK = 64
ATT_HEADS = 8
ATT_DIM = 64
ATT_WIDTH = ATT_HEADS * ATT_DIM
DILATED_PATTERNS = ((128, 1), (512, 4), (2048, 16))
ATT_BLOCK = 128
ROPE_THETA = 10000.0
MIX_WIDTH = HG_WIDTH + ATT_WIDTH
N_IN_SPLITS = 8
IN_COLS = 5 * HG_WIDTH + 3 * ATT_WIDTH
N_EXPERTS = 32
TOP_K = 4
D_EXPERT = D_MODEL
SWIGLU_LIMIT = 7.0
SWIGLU_ALPHA = 1.702
MOE_BLOCK = 128
EPS = 1e-6
NEG = -1e30

kernel_name = "hybrid_hgrn2_dilated_attn_moe_encoder"


def rms_norm(x, g):
    xf = x.astype(jnp.float32)
    y = xf * lax.rsqrt(jnp.mean(xf * xf, axis=-1, keepdims=True) + EPS)
    return (y * g.astype(jnp.float32)).astype(x.dtype)


def rope(x, positions):
    half = x.shape[-1] // 2
    inv = 1.0 / (ROPE_THETA ** (jnp.arange(half, dtype=jnp.float32) / half))
    ang = positions.astype(jnp.float32)[..., None] * inv
    cos = jnp.cos(ang)[:, :, None, :]
    sin = jnp.sin(ang)[:, :, None, :]
    x1, x2 = x[..., :half], x[..., half:]
    return jnp.concatenate([x1 * cos - x2 * sin, x2 * cos + x1 * sin], axis=-1)


def banded_attention(q, k, v, half):
    B, H, L, Dh = q.shape
    nb = -(-L // ATT_BLOCK)
    Lp = nb * ATT_BLOCK
    W = ATT_BLOCK + 2 * half
    qb = jnp.pad(q, ((0, 0), (0, 0), (0, Lp - L), (0, 0))).reshape(B, H, nb, ATT_BLOCK, Dh)
    kpad = ((0, 0), (0, 0), (half, Lp - L + half), (0, 0))
    key_idx = jnp.arange(nb)[:, None] * ATT_BLOCK + jnp.arange(W)[None, :]
    kb = jnp.pad(k, kpad)[:, :, key_idx]
    vb = jnp.pad(v, kpad)[:, :, key_idx]
    s = jnp.einsum('bhnqd,bhnkd->bhnqk', qb, kb) * (Dh ** -0.5)
    qpos = jnp.arange(nb)[:, None] * ATT_BLOCK + jnp.arange(ATT_BLOCK)[None, :]
    kpos = key_idx - half
    rel = kpos[:, None, :] - qpos[:, :, None]
    valid = (jnp.abs(rel) <= half) & ((kpos >= 0) & (kpos < L))[:, None, :]
    s = jnp.where(valid, s, NEG)
    m = jnp.max(s, axis=-1, keepdims=True)
    p = jnp.exp(s - m)
    den = jnp.sum(p, axis=-1)
    o = jnp.einsum('bhnqk,bhnkd->bhnqd', p, vb) / den[..., None]
    lse = m[..., 0] + jnp.log(den)
    return o.reshape(B, H, Lp, Dh)[:, :, :L], lse.reshape(B, H, Lp)[:, :, :L]


def dilated_attention(q, k, v):
    B, S, H, Dh = q.shape
    outs, lses = [], []
    for window, dil in DILATED_PATTERNS:
        half = window // (2 * dil)
        L = S // dil
        def to_strided(t):
            return t.reshape(B, L, dil, H, Dh).transpose(0, 2, 3, 1, 4).reshape(B, dil * H, L, Dh)
        o, lse = banded_attention(to_strided(q), to_strided(k), to_strided(v), half)
        outs.append(o.reshape(B, dil, H, L, Dh).transpose(0, 3, 1, 2, 4).reshape(B, S, H, Dh))
        lses.append(lse.reshape(B, dil, H, L).transpose(0, 3, 1, 2).reshape(B, S, H))
    w = jax.nn.softmax(jnp.stack(lses, axis=0), axis=0)
    return jnp.sum(w[..., None] * jnp.stack(outs, axis=0), axis=0)


def gla_chunk_scan(q, k, v, log_f):
    B, H, S, dk = q.shape
    dv = v.shape[-1]
    N = S // HG_CHUNK
    C = HG_CHUNK
    q = q.reshape(B, H, N, C, dk)
    k = k.reshape(B, H, N, C, dk)
    v = v.reshape(B, H, N, C, dv)
    b = jnp.cumsum(log_f.reshape(B, H, N, C, dk), axis=3)
    b_last = b[:, :, :, -1:, :]
    qt = q * jnp.exp(b)
    kt = k * jnp.exp(-b)
    A = jnp.einsum('bhncd,bhnsd->bhncs', qt, kt)
    A = jnp.where(jnp.tril(jnp.ones((C, C), dtype=bool)), A, 0.0)
    o_intra = jnp.einsum('bhncs,bhnse->bhnce', A, v)
    U = jnp.einsum('bhncd,bhnce->bhnde', k * jnp.exp(b_last - b), v)
    a = jnp.exp(b_last[:, :, :, 0, :])

    def step(state, inp):
        a_n, U_n = inp
        return a_n[..., None] * state + U_n, state

    _, s_prev = lax.scan(step, jnp.zeros((B, H, dk, dv), q.dtype),
                         (jnp.moveaxis(a, 2, 0), jnp.moveaxis(U, 2, 0)))
    o_inter = jnp.einsum('bhncd,bhnde->bhnce', qt, jnp.moveaxis(s_prev, 0, 2))
    return (o_intra + o_inter).reshape(B, H, S, dv)


def hgrn2_mixer(hq, hf_fwd, hf_bwd, hi, hg, lb, onorm_g):
    B, S, _ = hq.shape

    def heads(t):
        return t.astype(jnp.float32).reshape(B, S, HG_HEADS, HG_DIM).transpose(0, 2, 1, 3)

    def gate(z, lbd):
        z = z.astype(jnp.float32)
        f = lbd + (1.0 - lbd) * jax.nn.sigmoid(z)
        k = (1.0 - lbd) * jax.nn.sigmoid(-z)
        return heads(k), heads(jnp.log(f))

    q = heads(jax.nn.silu(hq.astype(jnp.float32)))
    v = heads(hi)
    k_f, g_f = gate(hf_fwd, lb[0])
    k_b, g_b = gate(hf_bwd, lb[1])
    fwd = gla_chunk_scan(q, k_f, v, g_f)
    flip = lambda t: jnp.flip(t, axis=2)
    bwd = flip(gla_chunk_scan(flip(q), flip(k_b), flip(v), flip(g_b)))
    o = (fwd + bwd).transpose(0, 2, 1, 3)
    o = rms_norm(o, onorm_g) * jax.nn.silu(hg.astype(jnp.float32).reshape(B, S, HG_HEADS, HG_DIM))
    return o.reshape(B, S, HG_WIDTH)


def clamped_swiglu(h):
    glu = jnp.minimum(h[..., ::2], SWIGLU_LIMIT)
    lin = jnp.clip(h[..., 1::2], -SWIGLU_LIMIT, SWIGLU_LIMIT)
    return glu * jax.nn.sigmoid(SWIGLU_ALPHA * glu) * (lin + 1.0)


def moe_ffn(h, w_router, b_router, w_up, b_up, w_down, b_down):
    B, S, D = h.shape
    N = B * S
    xt = h.reshape(N, D)
    logits = (xt @ w_router + b_router).astype(jnp.float32)
    top_val, top_idx = lax.top_k(logits, TOP_K)
    gates = jax.nn.softmax(top_val, axis=-1)
    A = N * TOP_K
    e_flat = top_idx.reshape(A)
    t_flat = jnp.arange(A, dtype=jnp.int32) // TOP_K
    g_flat = gates.reshape(A)
    order = jnp.argsort(e_flat, stable=True)
    e_s, t_s, g_s = e_flat[order], t_flat[order], g_flat[order]
    counts = jnp.bincount(e_flat, length=N_EXPERTS)
    padded = ((counts + MOE_BLOCK - 1) // MOE_BLOCK) * MOE_BLOCK
    pad_end = jnp.cumsum(padded)
    pad_start = pad_end - padded
    raw_start = jnp.cumsum(counts) - counts
    dest = pad_start[e_s] + (jnp.arange(A) - raw_start[e_s])
    P = (-(-A // MOE_BLOCK)) * MOE_BLOCK + N_EXPERTS * MOE_BLOCK
    nb = P // MOE_BLOCK
    row_tok = jnp.zeros((P,), jnp.int32).at[dest].set(t_s)
    row_gate = jnp.zeros((P,), jnp.float32).at[dest].set(g_s)
    block_exp = jnp.minimum(jnp.searchsorted(pad_end, jnp.arange(nb) * MOE_BLOCK, side='right'),
                            N_EXPERTS - 1)

    def expert_block(args):
        tok, gate, e = args
        xb = xt[tok]
        hu = xb @ w_up[e] + b_up[e]
        y = clamped_swiglu(hu) @ w_down[e] + b_down[e]
        return y.astype(jnp.float32) * gate[:, None]

    y = lax.map(expert_block, (row_tok.reshape(nb, MOE_BLOCK), row_gate.reshape(nb, MOE_BLOCK), block_exp))
    out = jax.ops.segment_sum(y.reshape(P, D), row_tok, num_segments=N)
    return out.reshape(B, S, D).astype(h.dtype)


def setup_inputs(seed: int = 0) -> dict:
    key = jax.random.key(seed)
    ks = jax.random.split(key, 16)
    f32 = jnp.float32
    nrm = lambda k, shape, s: jax.random.normal(k, shape, f32) * s
    return {
        "x": nrm(ks[0], (BATCH, SEQ, D_MODEL), 1.0),
        "positions": jnp.broadcast_to(jnp.arange(SEQ, dtype=jnp.int32), (BATCH, SEQ)),
        "norm1_g": 1.0 + nrm(ks[1], (DEPTH, D_MODEL), 0.02),
        "w_in": nrm(ks[2], (DEPTH, D_MODEL, IN_COLS), D_MODEL ** -0.5),
        "q_norm_g": 1.0 + nrm(ks[3], (DEPTH, ATT_DIM), 0.02),
        "k_norm_g": 1.0 + nrm(ks[4], (DEPTH, ATT_DIM), 0.02),
        "hgrn_lower_bounds": nrm(ks[5], (DEPTH + 1, 2, HG_WIDTH), 0.1),
        "hgrn_onorm_g": 1.0 + nrm(ks[6], (DEPTH, HG_DIM), 0.02),
        "w_out": nrm(ks[7], (DEPTH, MIX_WIDTH, D_MODEL), MIX_WIDTH ** -0.5),
        "norm2_g": 1.0 + nrm(ks[8], (DEPTH, D_MODEL), 0.02),
        "w_router": nrm(ks[9], (DEPTH, D_MODEL, N_EXPERTS), D_MODEL ** -0.5),
        "b_router": nrm(ks[10], (DEPTH, N_EXPERTS), 0.01),
        "w_up": nrm(ks[11], (DEPTH, N_EXPERTS, D_MODEL, 2 * D_EXPERT), D_MODEL ** -0.5),
        "b_up": nrm(ks[12], (DEPTH, N_EXPERTS, 2 * D_EXPERT), 0.01),
        "w_down": nrm(ks[13], (DEPTH, N_EXPERTS, D_EXPERT, D_MODEL), D_EXPERT ** -0.5),
        "b_down": nrm(ks[14], (DEPTH, N_EXPERTS, D_MODEL), 0.01),
    }


def reference(x, positions, norm1_g, w_in, q_norm_g, k_norm_g, hgrn_lower_bounds, hgrn_onorm_g,
              w_out, norm2_g, w_router, b_router, w_up, b_up, w_down, b_down):
    B, S, _ = x.shape
    lbs = jnp.cumsum(jax.nn.softmax(hgrn_lower_bounds.astype(jnp.float32), axis=0), axis=0)
    for l in range(DEPTH):
        h = rms_norm(x, norm1_g[l])
        proj = h @ w_in[l]
        hq, hf_fwd, hf_bwd, hi, hg, aq, ak, av = jnp.split(proj, N_IN_SPLITS, axis=-1)
        o_hg = hgrn2_mixer(hq, hf_fwd, hf_bwd, hi, hg, lbs[l], hgrn_onorm_g[l])
        to_heads = lambda t: t.astype(jnp.float32).reshape(B, S, ATT_HEADS, ATT_DIM)
        q = rope(rms_norm(to_heads(aq), q_norm_g[l]), positions)
        k = rope(rms_norm(to_heads(ak), k_norm_g[l]), positions)
        o_att = dilated_attention(q, k, to_heads(av)).reshape(B, S, ATT_WIDTH)
        mix = jnp.concatenate([o_hg.astype(x.dtype), o_att.astype(x.dtype)], axis=-1)
        x = x + mix @ w_out[l]
        x = x + moe_ffn(rms_norm(x, norm2_g[l]), w_router[l], b_router[l], w_up[l], b_up[l],
                        w_down[l], b_down[l])
    return x
```

```cpp
#include <hip/hip_runtime.h>
#include <cstdio>
#include <cstdint>
namespace pg8 {
#define PG8_LAS __attribute__((address_space(3)))
typedef unsigned short bf16_t;
typedef short bf16x8 __attribute__((ext_vector_type(8)));
typedef float f32x4 __attribute__((ext_vector_type(4)));
typedef unsigned u32x4 __attribute__((ext_vector_type(4)));
constexpr int BM = 256, BK = 64, HALF = 128, HTB = HALF * BK * 2  , STAGE_BYTES = 8 * HTB, NXCD = 8, WGM = 8;

__host__ __device__ __forceinline__ int lds_byte(int r, int c) { const int st = (r >> 4) * 2 + (c >> 5), rr = r & 15, cc = c & 31, ob = rr * 64 + cc * 2; return st * 1024 + (ob ^ (((ob >> 9) & 1) << 5)); }
__host__ __device__ __forceinline__ void stage_rc(int b, int& R, int& C) { const int st = b / 1024, sb = b % 1024, swz = sb ^ (((sb >> 9) & 1) << 5); R = (st >> 1) * 16 + swz / 64; C = (st & 1) * 32 + (swz % 64) / 2; }
__host__ __device__ __forceinline__ int perm32(int rho) { const int n = rho >> 4, i = rho & 15; return 8 * (i >> 2) + 4 * n + (i & 3); }

struct Unit { int pm, pn; };
struct Gemm { const bf16_t* A; const bf16_t* Bt; int M, N, K; };

struct StaticOrder {
    int nM, nN, nwg, G, c;
    __host__ __device__ void init(int M, int N, int G_, int c_) { nM = M / BM; nN = N / BM; nwg = nM * nN; G = G_; c = c_; }
    __host__ __device__ bool next(int i, Unit& u) const {
        const long L = (long)i * G + c; if (L >= nwg) return false;
        int wgid = (int)L; { const int q = nwg / NXCD, r = nwg % NXCD, xcd = wgid % NXCD, off = wgid / NXCD; wgid = (xcd < r ? xcd * (q + 1) : r * (q + 1) + (xcd - r) * q) + off; }
        const int nig = WGM * nN, gid = wgid / nig, fm = gid * WGM, gsz = (nM - fm) < WGM ? (nM - fm) : WGM;
        u.pm = fm + ((wgid % nig) % gsz); u.pn = (wgid % nig) / gsz; return true;
    }
    __device__ __forceinline__ void a_ready(const Unit&) const {}
    __device__ __forceinline__ void done(const Unit&) const {}
};

__device__ __forceinline__ unsigned cvt_pk_bf16(float lo, float hi) { unsigned r; asm volatile("v_cvt_pk_bf16_f32 %0, %1, %2" : "=v"(r) : "v"(lo), "v"(hi)); return r; }
typedef float f32x2 __attribute__((ext_vector_type(2)));
__device__ __forceinline__ f32x2 gelu_pk(f32x2 v) {
    const f32x2 av = __builtin_elementwise_abs(v), d = av * 0.2316418882f + 1.0f;
    f32x2 t; t.x = __builtin_amdgcn_rcpf(d.x); t.y = __builtin_amdgcn_rcpf(d.y);
    f32x2 q = t * 0.5307027145f + (-0.7265760135f); q = q * t + 0.7107068705f; q = q * t + (-0.142248368f); q = q * t + 0.127414796f; q = q * t;
    const f32x2 s = (v * v) * (-0.72134752044f);
    f32x2 e; e.x = __builtin_amdgcn_exp2f(s.x); e.y = __builtin_amdgcn_exp2f(s.y);
    const f32x2 m = v * (q * e), r = v - m;
    f32x2 o; o.x = v.x < 0.f ? m.x : r.x; o.y = v.y < 0.f ? m.y : r.y; return o;
}

template <int ACT  > struct EpiBf16 {
    static constexpr bool PERM = true, AFTER_DRAIN = false; static_assert(ACT == 0 || ACT == 1, "EpiBf16: ACT is 0 (none) or 1 (gelu_pk)");
    bf16_t* O; int ldc; const float* bias; int split_cols; size_t split_stride; float scale0;
    __device__ __forceinline__ void operator()(const f32x4 (&acc)[2][2][4][2], const Unit& u, int wr, int wc, int fr, int fq) const {
        const int row0 = u.pm * BM + wr * 64 + fr; int colt = u.pn * BM; bf16_t* base = O;
        float sc = 1.f; if (split_cols) { const int t = colt / split_cols; base += (size_t)t * split_stride; colt -= t * split_cols; if (t == 0) sc = scale0; }
        const int col0 = colt + wc * 32 + 8 * fq, bcol0 = u.pn * BM + wc * 32 + 8 * fq;
        f32x4 bv[2][2];
#pragma unroll
        for (int bj = 0; bj < 2; ++bj)
#pragma unroll
            for (int n = 0; n < 2; ++n) bv[bj][n] = bias ? *(const f32x4*)(bias + bcol0 + bj * HALF + 4 * n) : (f32x4){0.f, 0.f, 0.f, 0.f};
#pragma unroll
        for (int ai = 0; ai < 2; ++ai)
#pragma unroll
            for (int m = 0; m < 4; ++m) { bf16_t* rowp = base + (size_t)(row0 + ai * HALF + m * 16) * ldc + col0;
#pragma unroll
                for (int bj = 0; bj < 2; ++bj) { f32x4 v0 = acc[ai][bj][m][0] + bv[bj][0], v1 = acc[ai][bj][m][1] + bv[bj][1];
                    if (ACT == 1) { f32x2 a = gelu_pk((f32x2){v0[0], v0[1]}), b = gelu_pk((f32x2){v0[2], v0[3]}), c = gelu_pk((f32x2){v1[0], v1[1]}), d = gelu_pk((f32x2){v1[2], v1[3]});
                        v0 = (f32x4){a.x, a.y, b.x, b.y}; v1 = (f32x4){c.x, c.y, d.x, d.y}; }
                    v0 = v0 * sc; v1 = v1 * sc; u32x4 w; w.x = cvt_pk_bf16(v0[0], v0[1]); w.y = cvt_pk_bf16(v0[2], v0[3]); w.z = cvt_pk_bf16(v1[0], v1[1]); w.w = cvt_pk_bf16(v1[2], v1[3]);
                    *(u32x4*)(rowp + bj * HALF) = w; } }
    }
};

struct EpiResF32 {
    static constexpr bool PERM = false, AFTER_DRAIN = false;
    const float* base; float* out; int ldc;
    __device__ __forceinline__ void operator()(const f32x4 (&acc)[2][2][4][2], const Unit& u, int wr, int wc, int fr, int fq) const {
        const int row0 = u.pm * BM + wr * 64 + fr, col0 = u.pn * BM + wc * 32 + 4 * fq;
#pragma unroll
        for (int ai = 0; ai < 2; ++ai)
#pragma unroll
            for (int m = 0; m < 4; ++m) { const size_t off = (size_t)(row0 + ai * HALF + m * 16) * ldc + col0;
#pragma unroll
                for (int bj = 0; bj < 2; ++bj)
#pragma unroll
                    for (int n = 0; n < 2; ++n) *(f32x4*)(out + off + bj * HALF + n * 16) = *(const f32x4*)(base + off + bj * HALF + n * 16) + acc[ai][bj][m][n]; }
    }
};
__device__ __forceinline__ float sigmoid_fast(float x) { return __builtin_amdgcn_rcpf(1.0f + __builtin_amdgcn_exp2f(-1.4426950408889634f * x)); }
struct EpiSwiglu {
    static constexpr bool PERM = true, AFTER_DRAIN = false;
    bf16_t* ACT; const float* b_up;
    __device__ __forceinline__ void operator()(const f32x4 (&acc)[2][2][4][2], const Unit& u, int wr, int wc, int fr, int fq) const {
        const int e = u.pn >> 3, pnl = u.pn & 7;
        const int row0 = u.pm * BM + wr * 64 + fr, j0 = pnl * 128 + wc * 32 + 8 * fq;
        const float* bp = b_up + (size_t)e * 2048 + 2 * j0;
        const f32x4 b0 = *(const f32x4*)(bp), b1 = *(const f32x4*)(bp + 4), b2 = *(const f32x4*)(bp + 8), b3 = *(const f32x4*)(bp + 12);
        const float bg[8] = {b0[0], b0[2], b1[0], b1[2], b2[0], b2[2], b3[0], b3[2]};
        const float bl[8] = {b0[1], b0[3], b1[1], b1[3], b2[1], b2[3], b3[1], b3[3]};
#pragma unroll
        for (int ai = 0; ai < 2; ++ai)
#pragma unroll
            for (int m = 0; m < 4; ++m) {
                float o[8];
#pragma unroll
                for (int n = 0; n < 2; ++n)
#pragma unroll
                    for (int i = 0; i < 4; ++i) {
                        float g = acc[ai][0][m][n][i] + bg[4 * n + i], l = acc[ai][1][m][n][i] + bl[4 * n + i];
                        g = fminf(g, 7.0f); l = fminf(fmaxf(l, -7.0f), 7.0f);
                        o[4 * n + i] = g * sigmoid_fast(1.702f * g) * (l + 1.0f);
                    }
                u32x4 w; w.x = cvt_pk_bf16(o[0], o[1]); w.y = cvt_pk_bf16(o[2], o[3]); w.z = cvt_pk_bf16(o[4], o[5]); w.w = cvt_pk_bf16(o[6], o[7]);
                *(u32x4*)(ACT + (size_t)(row0 + ai * HALF + m * 16) * 1024 + j0) = w;
            }
    }
};
struct EpiDown {
    static constexpr bool PERM = true, AFTER_DRAIN = false;
    bf16_t* Y; const float* b_down; const float* row_gate;
    __device__ __forceinline__ void operator()(const f32x4 (&acc)[2][2][4][2], const Unit& u, int wr, int wc, int fr, int fq) const {
        const int e = u.pn >> 2, pnl = u.pn & 3;
        const int row0 = u.pm * BM + wr * 64 + fr, col0 = pnl * BM + wc * 32 + 8 * fq;
        f32x4 bv[2][2];
#pragma unroll
        for (int bj = 0; bj < 2; ++bj)
#pragma unroll
            for (int n = 0; n < 2; ++n) bv[bj][n] = *(const f32x4*)(b_down + (size_t)e * 1024 + col0 + bj * HALF + 4 * n);
#pragma unroll
        for (int ai = 0; ai < 2; ++ai)
#pragma unroll
            for (int m = 0; m < 4; ++m) { const int row = row0 + ai * HALF + m * 16; const float gt = row_gate[row];
#pragma unroll
                for (int bj = 0; bj < 2; ++bj) { const f32x4 v0 = (acc[ai][bj][m][0] + bv[bj][0]) * gt, v1 = (acc[ai][bj][m][1] + bv[bj][1]) * gt;
                    u32x4 w; w.x = cvt_pk_bf16(v0[0], v0[1]); w.y = cvt_pk_bf16(v0[2], v0[3]); w.z = cvt_pk_bf16(v1[0], v1[1]); w.w = cvt_pk_bf16(v1[2], v1[3]);
                    *(u32x4*)(Y + (size_t)row * 1024 + col0 + bj * HALF) = w; } }
    }
};
struct MoeOrder {
    int nNl, nunits, G, c; const PG8_LAS unsigned char* texp;
    __device__ __forceinline__ bool next(int i, Unit& u) const {
        const long L = (long)i * G + c; if (L >= nunits) return false;
        int wgid = (int)L; { const int q = nunits / NXCD, r = nunits % NXCD, xcd = wgid % NXCD, off = wgid / NXCD; wgid = (xcd < r ? xcd * (q + 1) : r * (q + 1) + (xcd - r) * q) + off; }
        const int rt = wgid / nNl, pnl = wgid - rt * nNl;
        u.pm = rt; u.pn = (int)texp[rt] * nNl + pnl; return true;
    }
    __device__ __forceinline__ void a_ready(const Unit&) const {}
    __device__ __forceinline__ void done(const Unit&) const {}
};
template <class Epi, class Sched, bool ALIGN_EPI = false, bool SP2 = false>
__device__ __forceinline__ void gemm_phase(PG8_LAS unsigned char* lds, const Gemm g, const Sched& S, const Epi& E) {
    const int tid = threadIdx.x, wid = __builtin_amdgcn_readfirstlane(tid >> 6), lane = tid & 63, wr = wid >> 2, wc = wid & 3, fr = lane & 15, fq = lane >> 4;
    const int K = g.K, nt = K / BK;
    unsigned voffA[2], voffB[2];
#pragma unroll
    for (int i = 0; i < 2; ++i) { int R, C; stage_rc(tid * 16 + i * 8192, R, C); const int Rb = Epi::PERM ? ((R & ~31) + perm32(R & 31)) : R;
        voffA[i] = (unsigned)(R * K + C) * 2u; voffB[i] = (unsigned)(Rb * K + C) * 2u; }
    const size_t kstep = (size_t)(BK * 2);
    const size_t hstep = (size_t)HALF * K * 2;
    const size_t tstep = 2 * hstep;
    const unsigned ldsw = (unsigned)wid * 1024u;
    const int aoff = lds_byte(wr * 64 + fr, fq * 8), boff = lds_byte(wc * 32 + fr, fq * 8);
#define PG8_SA(b, h) (((b) * 2 + (h)) * HTB)
#define PG8_SB(b, h) ((4 + (b) * 2 + (h)) * HTB)
#define PG8_STAGE(bufoff, gbase, voff) do { _Pragma("unroll") for (int _i = 0; _i < 2; ++_i) \
        __builtin_amdgcn_global_load_lds((const unsigned*)((const char*)(gbase) + (voff)[_i]), (PG8_LAS unsigned*)(lds + (bufoff) + ldsw + _i * 8192), 16, 0, 0); } while (0)
#define PG8_LDA(dst, b, h) do { _Pragma("unroll") for (int m = 0; m < 4; ++m) _Pragma("unroll") for (int k = 0; k < 2; ++k) dst[m][k] = *(const PG8_LAS bf16x8*)(lds + PG8_SA(b, h) + aoff + m * 2048 + k * 1024); } while (0)
#define PG8_LDB(dst, b, h) do { _Pragma("unroll") for (int n = 0; n < 2; ++n) _Pragma("unroll") for (int k = 0; k < 2; ++k) dst[n][k] = *(const PG8_LAS bf16x8*)(lds + PG8_SB(b, h) + boff + n * 2048 + k * 1024); } while (0)
#define PG8_MMA(ai, bj, At, Bt) do { __builtin_amdgcn_s_setprio(1); _Pragma("unroll") for (int m = 0; m < 4; ++m) _Pragma("unroll") for (int n = 0; n < 2; ++n) _Pragma("unroll") for (int k = 0; k < 2; ++k) \
        acc[ai][bj][m][n] = __builtin_amdgcn_mfma_f32_16x16x32_bf16(Bt[n][k], At[m][k], acc[ai][bj][m][n], 0, 0, 0); __builtin_amdgcn_s_setprio(0); } while (0)
#define PG8_WAIT_V(n) asm volatile("s_waitcnt vmcnt(" #n ")" ::: "memory")
#define PG8_WAIT_L(n) asm volatile("s_waitcnt lgkmcnt(" #n ")" ::: "memory")
#define PG8_BAR __builtin_amdgcn_s_barrier()
#define PG8_SCHED __builtin_amdgcn_sched_barrier(0)
    Unit cur, nxt; int ui = 0;
    if (!S.next(0, cur)) return;
    f32x4 acc[2][2][4][2];
#pragma unroll
    for (int a = 0; a < 2; ++a)
#pragma unroll
        for (int b = 0; b < 2; ++b)
#pragma unroll
            for (int m = 0; m < 4; ++m)
#pragma unroll
                for (int n = 0; n < 2; ++n) acc[a][b][m][n] = (f32x4){0.f, 0.f, 0.f, 0.f};
    bf16x8 At[4][2], B0[2][2], B1[2][2];
    const char* cA = (const char*)g.A + (size_t)cur.pm * tstep; const char* cB = (const char*)g.Bt + (size_t)cur.pn * tstep;
    S.a_ready(cur);
    if constexpr (SP2) {
        PG8_STAGE(PG8_SB(0, 0), cB, voffB); PG8_STAGE(PG8_SB(0, 1), cB + hstep, voffB); PG8_STAGE(PG8_SA(0, 0), cA, voffA); PG8_STAGE(PG8_SA(0, 1), cA + hstep, voffA);
        if (wr == 1) PG8_BAR;
        PG8_WAIT_V(2); PG8_BAR;
        PG8_STAGE(PG8_SB(1, 0), cB + kstep, voffB); PG8_STAGE(PG8_SA(1, 0), cA + kstep, voffA); PG8_STAGE(PG8_SB(1, 1), cB + hstep + kstep, voffB);
        PG8_WAIT_V(6); PG8_BAR;
    } else {
        PG8_STAGE(PG8_SB(0, 0), cB, voffB); PG8_STAGE(PG8_SA(0, 0), cA, voffA); PG8_STAGE(PG8_SB(0, 1), cB + hstep, voffB); PG8_STAGE(PG8_SA(0, 1), cA + hstep, voffA);
        if (wr == 1) PG8_BAR;
        PG8_WAIT_V(4); PG8_BAR;
        PG8_STAGE(PG8_SB(1, 0), cB + kstep, voffB); PG8_STAGE(PG8_SA(1, 0), cA + kstep, voffA); PG8_STAGE(PG8_SB(1, 1), cB + hstep + kstep, voffB);
        PG8_WAIT_V(6); PG8_BAR;
    }
    for (;;) {
        const bool has_next = S.next(ui + 1, nxt);
        const char* nA = has_next ? (const char*)g.A + (size_t)nxt.pm * tstep : cA; const char* nB = has_next ? (const char*)g.Bt + (size_t)nxt.pn * tstep : cB;
        for (int t = 0; t < nt; t += 2) {
            const bool last = (t == nt - 2);
            const char* a1 = cA + (size_t)(t + 1) * kstep;
            const char* a2 = last ? nA : cA + (size_t)(t + 2) * kstep; const char* b2 = last ? nB : cB + (size_t)(t + 2) * kstep;
            const char* a3 = a2 + kstep; const char* b3 = b2 + kstep;
            if (last && has_next) S.a_ready(nxt);
            if constexpr (SP2) {
            PG8_LDB(B0, 0, 0); PG8_LDB(B1, 0, 1); PG8_SCHED; PG8_LDA(At, 0, 0); PG8_STAGE(PG8_SA(1, 1), a1 + hstep, voffA);
            PG8_WAIT_V(8); PG8_WAIT_L(0); PG8_BAR; PG8_MMA(0, 0, At, B0); PG8_MMA(0, 1, At, B1); PG8_BAR; PG8_SCHED;
            PG8_LDA(At, 0, 1); PG8_STAGE(PG8_SB(0, 0), b2, voffB); PG8_STAGE(PG8_SB(0, 1), b2 + hstep, voffB); PG8_STAGE(PG8_SA(0, 0), a2, voffA);
            PG8_WAIT_V(8); PG8_WAIT_L(0); PG8_BAR; PG8_MMA(1, 0, At, B0); PG8_MMA(1, 1, At, B1); PG8_BAR; PG8_SCHED;
            PG8_LDB(B0, 1, 0); PG8_LDB(B1, 1, 1); PG8_SCHED; PG8_LDA(At, 1, 0); PG8_STAGE(PG8_SA(0, 1), a2 + hstep, voffA);
            PG8_WAIT_V(8); PG8_WAIT_L(0); PG8_BAR; PG8_MMA(0, 0, At, B0); PG8_MMA(0, 1, At, B1); PG8_BAR; PG8_SCHED;
            PG8_LDA(At, 1, 1); PG8_STAGE(PG8_SB(1, 0), b3, voffB); PG8_STAGE(PG8_SB(1, 1), b3 + hstep, voffB); PG8_STAGE(PG8_SA(1, 0), a3, voffA);
            PG8_WAIT_V(8); PG8_WAIT_L(0); PG8_BAR; PG8_MMA(1, 0, At, B0); PG8_MMA(1, 1, At, B1); PG8_BAR; PG8_SCHED;
            } else {
            PG8_LDB(B0, 0, 0); PG8_SCHED; PG8_LDA(At, 0, 0); PG8_STAGE(PG8_SA(1, 1), a1 + hstep, voffA);
            PG8_WAIT_L(8); PG8_BAR; PG8_WAIT_L(0); PG8_MMA(0, 0, At, B0); PG8_BAR; PG8_SCHED;
            PG8_LDB(B1, 0, 1); PG8_STAGE(PG8_SB(0, 0), b2, voffB);
            PG8_BAR; PG8_WAIT_L(0); PG8_MMA(0, 1, At, B1); PG8_BAR;
            PG8_LDA(At, 0, 1); PG8_STAGE(PG8_SA(0, 0), a2, voffA);
            PG8_BAR; PG8_WAIT_L(0); PG8_MMA(1, 0, At, B0); PG8_BAR; PG8_SCHED;
            PG8_STAGE(PG8_SB(0, 1), b2 + hstep, voffB);
            PG8_WAIT_V(6); PG8_BAR; PG8_MMA(1, 1, At, B1); PG8_BAR;
            PG8_LDB(B0, 1, 0); PG8_SCHED; PG8_LDA(At, 1, 0); PG8_STAGE(PG8_SA(0, 1), a2 + hstep, voffA);
            PG8_WAIT_L(8); PG8_BAR; PG8_WAIT_L(0); PG8_MMA(0, 0, At, B0); PG8_BAR; PG8_SCHED;
            PG8_LDB(B1, 1, 1); PG8_STAGE(PG8_SB(1, 0), b3, voffB);
            PG8_BAR; PG8_WAIT_L(0); PG8_MMA(0, 1, At, B1); PG8_BAR;
            PG8_LDA(At, 1, 1); PG8_STAGE(PG8_SA(1, 0), a3, voffA);
            PG8_BAR; PG8_WAIT_L(0); PG8_MMA(1, 0, At, B0); PG8_BAR; PG8_SCHED;
            PG8_STAGE(PG8_SB(1, 1), b3 + hstep, voffB);
            PG8_WAIT_V(6); PG8_BAR; PG8_MMA(1, 1, At, B1); PG8_BAR;
            }
        }
        if constexpr (ALIGN_EPI) { if (wr == 0) PG8_BAR; }
        if constexpr (!Epi::AFTER_DRAIN) { E(acc, cur, wr, wc, fr, fq); S.done(cur); }
        if (!has_next) break;
#pragma unroll
        for (int a = 0; a < 2; ++a)
#pragma unroll
            for (int b = 0; b < 2; ++b)
#pragma unroll
                for (int m = 0; m < 4; ++m)
#pragma unroll
                    for (int n = 0; n < 2; ++n) acc[a][b][m][n] = (f32x4){0.f, 0.f, 0.f, 0.f};
        cur = nxt; cA = nA; cB = nB; ++ui;
        if constexpr (ALIGN_EPI) { if (wr == 1) PG8_BAR; }
    }
    PG8_WAIT_V(0);
    if constexpr (!ALIGN_EPI) { if (wr == 0) PG8_BAR; }
    PG8_BAR;
    if constexpr (Epi::AFTER_DRAIN) { E.fused(acc, cur, wr, wc, fr, fq, lds, wid, lane); S.done(cur); }
#undef PG8_SA
#undef PG8_SB
#undef PG8_STAGE
#undef PG8_LDA
#undef PG8_LDB
#undef PG8_MMA
#undef PG8_WAIT_V
#undef PG8_WAIT_L
#undef PG8_BAR
#undef PG8_SCHED
}
}

constexpr int NWAVES = 8, NTHREADS = 512;
constexpr int BATCH = 2, SEQ = 8192, NTOK = BATCH * SEQ, DM = 1024, INC = 4096;
constexpr int NE = 32, TOPK = 4;
constexpr int PMAX = NTOK * TOPK + NE * 256;
constexpr int MAXTILES = PMAX / 256;
constexpr float EPS = 1e-6f;
constexpr int C_HQ = 0, C_HFF = 512, C_HFB = 1024, C_HI = 1536, C_HG = 2048, C_AQ = 2560, C_AK = 3072, C_AV = 3584;

#ifndef MK_PER_PHASE
#define MK_PER_PHASE 1
#endif
constexpr int NPHASE = 11;

constexpr size_t MiB = 1u << 20;
constexpr size_t WS_CTL = 0, CTL_ZERO_BYTES = 1 * MiB;
constexpr size_t WS_WIN = 2 * MiB, WS_WOUT = 10 * MiB, WS_WUP = 12 * MiB, WS_WDN = 140 * MiB;
constexpr size_t WS_XN = 204 * MiB, WS_PROJ = 236 * MiB, WS_CS = 364 * MiB, WS_QR = 368 * MiB, WS_KR = 384 * MiB;
constexpr size_t WS_MIX = 400 * MiB, WS_OF = 432 * MiB, WS_RT = 496 * MiB, WS_XS = 498 * MiB, WS_ACT = 642 * MiB, WS_END = 786 * MiB;
constexpr size_t RT_TOPE = 0, RT_TOPG = 256 * 1024, RT_SLOT = 512 * 1024, RT_HIST = 768 * 1024, RT_GATE = 1024 * 1024;
constexpr int CW_TMO = 0, CW_BAR = 4096;

constexpr int RING_BYTES = 131072;
constexpr int LDSCTL_OFF = RING_BYTES;
constexpr int MISC_OFF = LDSCTL_OFF;
constexpr int L_HIST = LDSCTL_OFF + 256;
constexpr int L_TOT = L_HIST + 128;
constexpr int L_MINE = L_TOT + 128;
constexpr int L_PADS = L_MINE + 128;
constexpr int L_TEXP = L_PADS + 256;
constexpr int L_ITE = L_TEXP + 512;
constexpr int L_ITP = L_ITE + 1024;
constexpr int L_HG = L_ITP + 1024;
constexpr int LDS_BYTES = 147456;
static_assert(L_HG + 12288 <= LDS_BYTES, "LDS map");

#define GAS __attribute__((address_space(1)))
#define LAS __attribute__((address_space(3)))
typedef unsigned short bf16;
typedef unsigned v4u __attribute__((ext_vector_type(4)));
typedef unsigned v2u __attribute__((ext_vector_type(2)));
typedef float f32x4 __attribute__((ext_vector_type(4)));
typedef GAS unsigned gu32;
#define RLX_AGENT __ATOMIC_RELAXED, __HIP_MEMORY_SCOPE_AGENT
#define LDS_WAIT() asm volatile("s_waitcnt lgkmcnt(0)" ::: "memory")
#define VM_WAIT() asm volatile("s_waitcnt vmcnt(0)" ::: "memory")
__device__ __forceinline__ unsigned f2bf(float f) { unsigned u = __builtin_bit_cast(unsigned, f); return (u + 0x7fffu + ((u >> 16) & 1u)) >> 16; }
__device__ __forceinline__ unsigned pk2(float lo, float hi) { return f2bf(lo) | (f2bf(hi) << 16); }
__device__ __forceinline__ float bf2f(unsigned b) { return __builtin_bit_cast(float, b << 16); }
__device__ __forceinline__ float bflo(unsigned w) { return __builtin_bit_cast(float, w << 16); }
__device__ __forceinline__ float bfhi(unsigned w) { return __builtin_bit_cast(float, w & 0xffff0000u); }
__device__ __forceinline__ float sigm(float x) { return 1.0f / (1.0f + __expf(-x)); }

#define XB_TMO      128
#define XB_XCNT(j)  (256  + 64 * (j))
#define XB_XSUB(j)  (1280 + 64 * (j))
#define XB_XGEN(j)  (2304 + 64 * (j))
#define XB_TOP      3328
#define XB_TOPGEN   3392
#define XCD_BAR_WORDS 3456
#define XB_SPIN_CAP (1u << 23)
__device__ __forceinline__ unsigned xb_ld(unsigned* p)              { return __hip_atomic_load(p, __ATOMIC_RELAXED, __HIP_MEMORY_SCOPE_AGENT); }
__device__ __forceinline__ unsigned xb_add(unsigned* p, unsigned v) { return __hip_atomic_fetch_add(p, v, __ATOMIC_RELAXED, __HIP_MEMORY_SCOPE_AGENT); }
__device__ __forceinline__ unsigned xb_xcc_id() { return (unsigned)__builtin_amdgcn_s_getreg((3 << 11) | 20) & 0xFu; }
#define XB_SPIN(cond, bar) do { unsigned _sp = 0; while (cond) { __builtin_amdgcn_s_sleep(1); \
    if ((++_sp & 255u) == 0u) { if (xb_ld(&(bar)[XB_TMO])) break; if (_sp > XB_SPIN_CAP) { atomicAdd(&(bar)[XB_TMO], 1u); break; } } } } while (0)
struct XcdBarrier { unsigned* bar; unsigned x; volatile LAS unsigned* st; };
__device__ __forceinline__ XcdBarrier xcd_barrier_post(unsigned* bar, volatile LAS unsigned* st) {
    XcdBarrier b; b.bar = bar; b.x = xb_xcc_id(); b.st = st;
    if (threadIdx.x == 0) (void)xb_add(&bar[XB_XCNT(b.x)], 1u);
    return b;
}
__device__ __forceinline__ void xcd_barrier_complete(unsigned* bar, unsigned x, unsigned& nloc, unsigned& nx) {
    const unsigned G = gridDim.x * gridDim.y * gridDim.z;
    unsigned sum, cnt, mine, sp = 0u;
    for (;;) {
        sum = 0u; cnt = 0u; mine = 0u;
#pragma unroll
        for (unsigned j = 0; j < 16; ++j) { const unsigned c = xb_ld(&bar[XB_XCNT(j)]); sum += c; cnt += (c > 0u) ? 1u : 0u; mine = (j == x) ? c : mine; }
        if (sum == G) break;
        __builtin_amdgcn_s_sleep(1);
        if ((++sp & 255u) == 0u) { if (xb_ld(&bar[XB_TMO])) break; if (sp > XB_SPIN_CAP) { atomicAdd(&bar[XB_TMO], 1u); break; } }
    }
    nloc = mine > 0u ? mine : 1u; nx = cnt > 0u ? cnt : 1u;
}
__device__ __forceinline__ void xcd_barrier(const XcdBarrier& b) {
    asm volatile("s_waitcnt vmcnt(0)" ::: "memory");
    __syncthreads();
    if (threadIdx.x == 0) {
        unsigned* bar = b.bar;
        __builtin_amdgcn_s_waitcnt(0);
        unsigned nloc = b.st[0], nx = b.st[1];
        if (nloc == 0u) { xcd_barrier_complete(bar, b.x, nloc, nx); b.st[0] = nloc; b.st[1] = nx; }
        const unsigned old = xb_add(&bar[XB_XSUB(b.x)], 1u);
        const unsigned gen = old / nloc;
        if (old + 1u == (gen + 1u) * nloc) {
            __builtin_amdgcn_fence(__ATOMIC_RELEASE, "agent");
            asm volatile("s_waitcnt vmcnt(0)" ::: "memory");
            const unsigned og = xb_add(&bar[XB_TOP], 1u);
            const unsigned tg = og / nx;
            if (og + 1u == (tg + 1u) * nx) xb_add(&bar[XB_TOPGEN], 1u);
            else XB_SPIN(xb_ld(&bar[XB_TOPGEN]) == tg, bar);
            __builtin_amdgcn_fence(__ATOMIC_ACQUIRE, "agent");
            xb_add(&bar[XB_XGEN(b.x)], 1u);
            asm volatile("s_waitcnt vmcnt(0)" ::: "memory");
        } else {
            XB_SPIN(xb_ld(&bar[XB_XGEN(b.x)]) == gen, bar);
            __builtin_amdgcn_fence(__ATOMIC_ACQUIRE, "agent");
            asm volatile("s_waitcnt vmcnt(0)" ::: "memory");
        }
    }
    __syncthreads();
}

__device__ __forceinline__ float wave_sum(float v) {
#pragma unroll
    for (int o = 1; o < 64; o <<= 1) v += __shfl_xor(v, o);
    return v;
}

struct Args {
    const float* x; const int* pos; const float* g1; const float* w_in; const float* qg; const float* kg; const float* lb; const float* og;
    const float* w_out; const float* g2; const float* w_r; const float* b_r; const float* w_up; const float* b_up; const float* w_dn; const float* b_dn;
    float* out; unsigned char* ws; int ph_lo, ph_hi;
};

__device__ __forceinline__ void p0_item(const float* W, int K, int N, bf16* WTrow0, int k0, int src_col0, int src_stride, LAS float* scr, int lane) {
#pragma unroll 8
    for (int i = 0; i < 32; ++i) { const int kk = 2 * i + (lane >> 5); scr[kk * 33 + (lane & 31)] = W[(size_t)(k0 + kk) * N + src_col0 + src_stride * (lane & 31)]; }
    LDS_WAIT(); asm volatile("" ::: "memory");
    const int c = lane & 7;
#pragma unroll
    for (int j = 0; j < 4; ++j) { const int n = (lane >> 3) + 8 * j; const LAS float* s = scr + (8 * c) * 33 + n;
        v4u o; o.x = pk2(s[0 * 33], s[1 * 33]); o.y = pk2(s[2 * 33], s[3 * 33]); o.z = pk2(s[4 * 33], s[5 * 33]); o.w = pk2(s[6 * 33], s[7 * 33]);
        *(GAS v4u*)(WTrow0 + (size_t)n * K + k0 + 8 * c) = o; }
    LDS_WAIT(); asm volatile("" ::: "memory");
}
__device__ __forceinline__ void p0_prologue(const Args& a, LAS unsigned char* lds, int gw, int NGW, int lane, int wave) {
    LAS float* scr = (LAS float*)(lds + wave * 16384);
    bf16* Win_t = (bf16*)(a.ws + WS_WIN); bf16* Wout_t = (bf16*)(a.ws + WS_WOUT); bf16* Wup_t = (bf16*)(a.ws + WS_WUP); bf16* Wdn_t = (bf16*)(a.ws + WS_WDN);
    constexpr int I_UP = NE * 16 * 64, I_DN = NE * 16 * 32, I_IN = 16 * 128, I_OUT = 16 * 32;
    constexpr int NITEMS = I_UP + I_DN + I_IN + I_OUT;
    for (int it = gw; it < NITEMS; it += NGW) {
        int r = it;
        if (r < I_UP) { const int e = r >> 10; r &= 1023; const int kb = r >> 6, q = r & 63, p = q & 1, j0 = (q >> 1) * 32;
            const int c0 = 256 * (j0 >> 7) + 128 * p + (j0 & 127);
            p0_item(a.w_up + (size_t)e * 1024 * 2048, 1024, 2048, Wup_t + ((size_t)e * 2048 + c0) * 1024, kb * 64, 2 * j0 + p, 2, scr, lane); continue; }
        r -= I_UP;
        if (r < I_DN) { const int e = r >> 9; r &= 511; const int kb = r >> 5, nb = r & 31;
            p0_item(a.w_dn + (size_t)e * 1024 * 1024, 1024, 1024, Wdn_t + ((size_t)e * 1024 + nb * 32) * 1024, kb * 64, nb * 32, 1, scr, lane); continue; }
        r -= I_DN;
        if (r < I_IN) { const int kb = r >> 7, nb = r & 127;
            p0_item(a.w_in, 1024, INC, Win_t + (size_t)(nb * 32) * 1024, kb * 64, nb * 32, 1, scr, lane); continue; }
        r -= I_IN;
        { const int kb = r >> 5, nb = r & 31;
            p0_item(a.w_out, 1024, 1024, Wout_t + (size_t)(nb * 32) * 1024, kb * 64, nb * 32, 1, scr, lane); }
    }
    bf16* XN = (bf16*)(a.ws + WS_XN);
    f32x4 g[4];
#pragma unroll
    for (int j = 0; j < 4; ++j) g[j] = ((const f32x4*)a.g1)[64 * j + lane];
    for (int m = gw; m < NTOK; m += NGW) {
        const f32x4* xr = (const f32x4*)(a.x + (size_t)m * DM) + lane;
        f32x4 v[4]; float s = 0.f;
#pragma unroll
        for (int j = 0; j < 4; ++j) { v[j] = xr[64 * j]; s += (v[j].x * v[j].x + v[j].y * v[j].y) + (v[j].z * v[j].z + v[j].w * v[j].w); }
        const float rstd = 1.0f / sqrtf(wave_sum(s) * (1.0f / DM) + EPS);
        v2u* o8 = (v2u*)(XN + (size_t)m * DM) + lane;
#pragma unroll
        for (int j = 0; j < 4; ++j) { v2u w; w.x = pk2(v[j].x * rstd * g[j].x, v[j].y * rstd * g[j].y); w.y = pk2(v[j].z * rstd * g[j].z, v[j].w * rstd * g[j].w); o8[64 * j] = w; }
    }
    float* CS = (float*)(a.ws + WS_CS);
    for (int idx = gw * 64 + lane; idx < NTOK * 32; idx += NGW * 64) {
        const int tok = idx >> 5, i = idx & 31;
        const float inv = exp2f(-(float)i * 0.41524101186092029f);
        const float ang = (float)a.pos[tok] * inv;
        double r = (double)ang * 0.15915494309189535; r -= floor(r);
        const float rf = (float)r;
        CS[(size_t)tok * 64 + i] = __builtin_amdgcn_cosf(rf); CS[(size_t)tok * 64 + 32 + i] = __builtin_amdgcn_sinf(rf);
    }
}

__device__ __forceinline__ void p2_qkprep(const Args& a, int gtid, int NGT) {
    const bf16* PROJ = (const bf16*)(a.ws + WS_PROJ); const float* CS = (const float*)(a.ws + WS_CS);
    for (int it = gtid; it < NTOK * 16; it += NGT) {
        const int tok = it >> 4, hh = it & 15, isk = hh >> 3, h = hh & 7;
        const v4u* src = (const v4u*)(PROJ + (size_t)tok * INC + (isk ? C_AK : C_AQ) + h * 64);
        float xv[64];
#pragma unroll
        for (int c = 0; c < 8; ++c) { const v4u w = src[c]; xv[8 * c + 0] = bflo(w.x); xv[8 * c + 1] = bfhi(w.x); xv[8 * c + 2] = bflo(w.y); xv[8 * c + 3] = bfhi(w.y);
            xv[8 * c + 4] = bflo(w.z); xv[8 * c + 5] = bfhi(w.z); xv[8 * c + 6] = bflo(w.w); xv[8 * c + 7] = bfhi(w.w); }
        float ss = 0.f;
#pragma unroll
        for (int i = 0; i < 64; ++i) ss += xv[i] * xv[i];
        const float rstd = (1.0f / sqrtf(ss * (1.0f / 64.0f) + EPS)) * (isk ? 1.0f : 0.125f);
        const float* gn = isk ? a.kg : a.qg;
        const float* cs = CS + (size_t)tok * 64;
        float ov[64];
#pragma unroll
        for (int i = 0; i < 32; ++i) { const float x1 = xv[i] * rstd * gn[i], x2 = xv[i + 32] * rstd * gn[i + 32], c = cs[i], s = cs[32 + i];
            ov[i] = x1 * c - x2 * s; ov[i + 32] = x2 * c + x1 * s; }
        v4u* dst = (v4u*)((bf16*)(a.ws + (isk ? WS_KR : WS_QR)) + (size_t)tok * 512 + h * 64);
#pragma unroll
        for (int c = 0; c < 8; ++c) { v4u w; w.x = pk2(ov[8 * c], ov[8 * c + 1]); w.y = pk2(ov[8 * c + 2], ov[8 * c + 3]); w.z = pk2(ov[8 * c + 4], ov[8 * c + 5]); w.w = pk2(ov[8 * c + 6], ov[8 * c + 7]); dst[c] = w; }
    }
}

__device__ __forceinline__ void p3_attn_naive(const Args& a, int gtid, int NGT) {
    const bf16* PROJ = (const bf16*)(a.ws + WS_PROJ); const bf16* QR = (const bf16*)(a.ws + WS_QR); const bf16* KR = (const bf16*)(a.ws + WS_KR);
    bf16* MIX = (bf16*)(a.ws + WS_MIX);
    for (int it = gtid; it < NTOK * 8; it += NGT) {
        const int tok = it >> 3, h = it & 7, b = tok / SEQ, t = tok % SEQ;
        float q[64], acc[64];
        { const v4u* src = (const v4u*)(QR + (size_t)tok * 512 + h * 64);
#pragma unroll
          for (int c = 0; c < 8; ++c) { const v4u w = src[c]; q[8 * c + 0] = bflo(w.x); q[8 * c + 1] = bfhi(w.x); q[8 * c + 2] = bflo(w.y); q[8 * c + 3] = bfhi(w.y);
              q[8 * c + 4] = bflo(w.z); q[8 * c + 5] = bfhi(w.z); q[8 * c + 6] = bflo(w.w); q[8 * c + 7] = bfhi(w.w); } }
#pragma unroll
        for (int i = 0; i < 64; ++i) acc[i] = 0.f;
        float m = -1e30f, l = 0.f;
        for (int p = 0; p < 3; ++p) { const int dil = 1 << (2 * p);
            for (int j = -64; j <= 64; ++j) { const int s = t + j * dil; if (s < 0 || s >= SEQ) continue;
                const size_t kt = (size_t)b * SEQ + s;
                const v4u* kp = (const v4u*)(KR + kt * 512 + h * 64); const v4u* vp = (const v4u*)(PROJ + kt * INC + C_AV + h * 64);
                float sc = 0.f;
#pragma unroll
                for (int c = 0; c < 8; ++c) { const v4u w = kp[c]; sc += q[8 * c] * bflo(w.x) + q[8 * c + 1] * bfhi(w.x) + q[8 * c + 2] * bflo(w.y) + q[8 * c + 3] * bfhi(w.y)
                    + q[8 * c + 4] * bflo(w.z) + q[8 * c + 5] * bfhi(w.z) + q[8 * c + 6] * bflo(w.w) + q[8 * c + 7] * bfhi(w.w); }
                const float mn = fmaxf(m, sc), corr = __expf(m - mn), pe = __expf(sc - mn);
                l = l * corr + pe; m = mn;
#pragma unroll
                for (int c = 0; c < 8; ++c) { const v4u w = vp[c];
                    acc[8 * c + 0] = acc[8 * c + 0] * corr + pe * bflo(w.x); acc[8 * c + 1] = acc[8 * c + 1] * corr + pe * bfhi(w.x);
                    acc[8 * c + 2] = acc[8 * c + 2] * corr + pe * bflo(w.y); acc[8 * c + 3] = acc[8 * c + 3] * corr + pe * bfhi(w.y);
                    acc[8 * c + 4] = acc[8 * c + 4] * corr + pe * bflo(w.z); acc[8 * c + 5] = acc[8 * c + 5] * corr + pe * bfhi(w.z);
                    acc[8 * c + 6] = acc[8 * c + 6] * corr + pe * bflo(w.w); acc[8 * c + 7] = acc[8 * c + 7] * corr + pe * bfhi(w.w); }
            } }
        const float il = 1.0f / l;
        v4u* dst = (v4u*)(MIX + (size_t)tok * 1024 + 512 + h * 64);
#pragma unroll
        for (int c = 0; c < 8; ++c) { v4u w; w.x = pk2(acc[8 * c] * il, acc[8 * c + 1] * il); w.y = pk2(acc[8 * c + 2] * il, acc[8 * c + 3] * il);
            w.z = pk2(acc[8 * c + 4] * il, acc[8 * c + 5] * il); w.w = pk2(acc[8 * c + 6] * il, acc[8 * c + 7] * il); dst[c] = w; }
    }
}

__device__ __forceinline__ void p3_hgrn_naive(const Args& a, LAS unsigned char* lds, int tid) {
    const bf16* PROJ = (const bf16*)(a.ws + WS_PROJ); float* OF = (float*)(a.ws + WS_OF);
    LAS float* FB = (LAS float*)(lds + L_HG);
    const int grp = tid >> 7, e = tid & 127, G = (int)blockIdx.x * 4 + grp, dir = G & 1, bh = G >> 1, b = bh >> 2, h = bh & 3;
    const float a0 = a.lb[dir * 512 + h * 128 + e], a1 = a.lb[1024 + dir * 512 + h * 128 + e];
    const float lbv = 1.0f / (1.0f + expf(a1 - a0));
    float S[128];
#pragma unroll
    for (int d = 0; d < 128; ++d) S[d] = 0.f;
    for (int step = 0; step < SEQ; ++step) {
        const int t = dir ? (SEQ - 1 - step) : step; const size_t tok = (size_t)b * SEQ + t;
        const bf16* pr = PROJ + tok * INC + h * 128 + e;
        const float z = bf2f(pr[dir ? C_HFB : C_HFF]), qraw = bf2f(pr[C_HQ]), vv = bf2f(pr[C_HI]);
        const float sg = sigm(z), f = lbv + (1.0f - lbv) * sg, k = (1.0f - lbv) * (1.0f - sg), qv = qraw * sigm(qraw);
        LAS float* fb = FB + ((step & 1) * 4 + grp) * 384;
        fb[e] = f; fb[128 + e] = k; fb[256 + e] = qv;
        __syncthreads();
        float o = 0.f;
#pragma unroll
        for (int d4 = 0; d4 < 32; ++d4) { const f32x4 F4 = *(const LAS f32x4*)(fb + 4 * d4), K4 = *(const LAS f32x4*)(fb + 128 + 4 * d4), Q4 = *(const LAS f32x4*)(fb + 256 + 4 * d4);
#pragma unroll
            for (int i = 0; i < 4; ++i) { S[4 * d4 + i] = F4[i] * S[4 * d4 + i] + K4[i] * vv; o += Q4[i] * S[4 * d4 + i]; } }
        OF[((size_t)dir * NTOK + tok) * 512 + h * 128 + e] = o;
    }
}

__device__ __forceinline__ void p4_hgrn_final(const Args& a, int gw, int NGW, int lane) {
    const bf16* PROJ = (const bf16*)(a.ws + WS_PROJ); const float* OF = (const float*)(a.ws + WS_OF); bf16* MIX = (bf16*)(a.ws + WS_MIX);
    const int c0 = 8 * lane;
    f32x4 gA = *(const f32x4*)(a.og + (c0 & 127)), gB = *(const f32x4*)(a.og + (c0 & 127) + 4);
    for (int tok = gw; tok < NTOK; tok += NGW) {
        const float* f0 = OF + (size_t)tok * 512 + c0; const float* f1 = OF + ((size_t)NTOK + tok) * 512 + c0;
        const f32x4 o0 = *(const f32x4*)f0 + *(const f32x4*)f1, o1 = *(const f32x4*)(f0 + 4) + *(const f32x4*)(f1 + 4);
        float ss = (o0.x * o0.x + o0.y * o0.y) + (o0.z * o0.z + o0.w * o0.w) + (o1.x * o1.x + o1.y * o1.y) + (o1.z * o1.z + o1.w * o1.w);
        ss += __shfl_xor(ss, 1); ss += __shfl_xor(ss, 2); ss += __shfl_xor(ss, 4); ss += __shfl_xor(ss, 8);
        const float rstd = 1.0f / sqrtf(ss * (1.0f / 128.0f) + EPS);
        const v4u hgw = *(const v4u*)(PROJ + (size_t)tok * INC + C_HG + c0);
        float hg[8] = {bflo(hgw.x), bfhi(hgw.x), bflo(hgw.y), bfhi(hgw.y), bflo(hgw.z), bfhi(hgw.z), bflo(hgw.w), bfhi(hgw.w)};
        float r[8] = {o0.x * gA.x, o0.y * gA.y, o0.z * gA.z, o0.w * gA.w, o1.x * gB.x, o1.y * gB.y, o1.z * gB.z, o1.w * gB.w};
#pragma unroll
        for (int i = 0; i < 8; ++i) r[i] = r[i] * rstd * hg[i] * sigm(hg[i]);
        v4u w; w.x = pk2(r[0], r[1]); w.y = pk2(r[2], r[3]); w.z = pk2(r[4], r[5]); w.w = pk2(r[6], r[7]);
        *(v4u*)(MIX + (size_t)tok * 1024 + c0) = w;
    }
}

__device__ __forceinline__ void p6_router(const Args& a, LAS unsigned char* lds, int tid, int lane, int wave) {
    LAS float* WrT = (LAS float*)lds;
    LAS int* lhist = (LAS int*)(lds + L_HIST);
    for (int idx = tid; idx < 32768; idx += NTHREADS) { const int k = idx >> 5, e = idx & 31; WrT[e * 1024 + k] = a.w_r[idx]; }
    if (tid < 32) lhist[tid] = 0;
    __syncthreads();
    bf16* XN = (bf16*)(a.ws + WS_XN);
    int* tope = (int*)(a.ws + WS_RT + RT_TOPE); float* topg = (float*)(a.ws + WS_RT + RT_TOPG); int* hist = (int*)(a.ws + WS_RT + RT_HIST);
    f32x4 g[4];
#pragma unroll
    for (int j = 0; j < 4; ++j) g[j] = ((const f32x4*)a.g2)[64 * j + lane];
    const float br = a.b_r[lane & 31];
    for (int blk = (int)blockIdx.x; blk < NTOK / 64; blk += (int)gridDim.x) {
        for (int rr = 0; rr < 8; ++rr) {
            const int row = blk * 64 + wave * 8 + rr;
            const f32x4* xr = (const f32x4*)(a.out + (size_t)row * DM) + lane;
            f32x4 v[4]; float s = 0.f;
#pragma unroll
            for (int j = 0; j < 4; ++j) { v[j] = xr[64 * j]; s += (v[j].x * v[j].x + v[j].y * v[j].y) + (v[j].z * v[j].z + v[j].w * v[j].w); }
            const float rstd = 1.0f / sqrtf(wave_sum(s) * (1.0f / DM) + EPS);
            v2u* o8 = (v2u*)(XN + (size_t)row * DM) + lane;
#pragma unroll
            for (int j = 0; j < 4; ++j) { v[j] = v[j] * rstd * g[j]; v2u w; w.x = pk2(v[j].x, v[j].y); w.y = pk2(v[j].z, v[j].w); o8[64 * j] = w; }
            float vals[32];
#pragma unroll
            for (int e = 0; e < 32; ++e) { float p = 0.f;
#pragma unroll
                for (int j = 0; j < 4; ++j) { const f32x4 w = *(const LAS f32x4*)(WrT + e * 1024 + 256 * j + 4 * lane); p += (v[j].x * w.x + v[j].y * w.y) + (v[j].z * w.z + v[j].w * w.w); }
                vals[e] = p; }
#pragma unroll
            for (int sft = 0; sft < 5; ++sft) { const int msk = 1 << sft; const bool up = (lane & msk) != 0;
#pragma unroll
                for (int i = 0; i < (16 >> sft); ++i) { const float lo = vals[2 * i], hi = vals[2 * i + 1]; const float send = up ? lo : hi, keep = up ? hi : lo; vals[i] = keep + __shfl_xor(send, msk); } }
            float logit = vals[0] + __shfl_xor(vals[0], 32) + br;
            int myi = lane & 31; float tv[4]; int ti[4]; float cur = logit;
#pragma unroll
            for (int k = 0; k < 4; ++k) { float bv = cur; int bi = myi;
#pragma unroll
                for (int o = 1; o < 32; o <<= 1) { const float ov = __shfl_xor(bv, o); const int oi = __shfl_xor(bi, o); if (ov > bv || (ov == bv && oi < bi)) { bv = ov; bi = oi; } }
                tv[k] = bv; ti[k] = bi; if (myi == bi) cur = -3.0e38f; }
            const float e1 = __expf(tv[1] - tv[0]), e2 = __expf(tv[2] - tv[0]), e3 = __expf(tv[3] - tv[0]); const float inv = 1.0f / (1.0f + e1 + e2 + e3);
            if (lane < 4) { const int ee = lane == 0 ? ti[0] : lane == 1 ? ti[1] : lane == 2 ? ti[2] : ti[3]; const float gg = (lane == 0 ? 1.0f : lane == 1 ? e1 : lane == 2 ? e2 : e3) * inv;
                tope[row * 4 + lane] = ee; topg[row * 4 + lane] = gg; __hip_atomic_fetch_add(&lhist[ee], 1, __ATOMIC_RELAXED, __HIP_MEMORY_SCOPE_WORKGROUP); }
        }
        __syncthreads();
        if (tid < 32) { hist[blk * 32 + tid] = lhist[tid]; lhist[tid] = 0; }
        __syncthreads();
    }
}

__device__ __forceinline__ void moe_tables(const Args& a, LAS unsigned char* lds, int tid, int blk) {
    const int* hist = (const int*)(a.ws + WS_RT + RT_HIST);
    LAS int* tot = (LAS int*)(lds + L_TOT); LAS int* mine = (LAS int*)(lds + L_MINE); LAS int* pads = (LAS int*)(lds + L_PADS); LAS unsigned char* texp = (LAS unsigned char*)(lds + L_TEXP);
    LAS int* part = (LAS int*)lds;
    { const int e = tid & 31, pt = tid >> 5; int t = 0, m = 0;
#pragma unroll
      for (int q = 0; q < 16; ++q) { const int b2 = pt * 16 + q; const int hv = hist[b2 * 32 + e]; t += hv; m += (b2 < blk) ? hv : 0; }
      part[pt * 32 + e] = t; part[512 + pt * 32 + e] = m; }
    __syncthreads();
    if (tid < 32) { int t = 0, m = 0;
#pragma unroll
      for (int q = 0; q < 16; ++q) { t += part[q * 32 + tid]; m += part[512 + q * 32 + tid]; }
      tot[tid] = t; mine[tid] = m; }
    __syncthreads();
    if (tid == 0) { int ps = 0, nt = 0;
#pragma unroll 1
        for (int e = 0; e < 32; ++e) { pads[e] = ps; const int tl = (tot[e] + 255) >> 8;
#pragma unroll 1
            for (int q = 0; q < tl; ++q) texp[nt + q] = (unsigned char)e;
            nt += tl; ps += tl * 256; } pads[32] = nt; }
    __syncthreads();
}

__device__ __forceinline__ void p7_gather(const Args& a, LAS unsigned char* lds, int tid, int lane, int wave) {
    const int* tope = (const int*)(a.ws + WS_RT + RT_TOPE); const float* topg = (const float*)(a.ws + WS_RT + RT_TOPG);
    int* slot = (int*)(a.ws + WS_RT + RT_SLOT); float* rgate = (float*)(a.ws + WS_RT + RT_GATE);
    const bf16* XN = (const bf16*)(a.ws + WS_XN); bf16* XS = (bf16*)(a.ws + WS_XS);
    LAS int* mine = (LAS int*)(lds + L_MINE); LAS int* pads = (LAS int*)(lds + L_PADS); LAS int* ite = (LAS int*)(lds + L_ITE); LAS int* itp = (LAS int*)(lds + L_ITP);
    for (int blk = (int)blockIdx.x; blk < NTOK / 64; blk += (int)gridDim.x) {
        moe_tables(a, lds, tid, blk);
        if (tid < 256) ite[tid] = tope[blk * 256 + tid];
        __syncthreads();
        if (tid < 32) { int rk = pads[tid] + mine[tid];
#pragma unroll 1
            for (int i = 0; i < 256; ++i) if (ite[i] == tid) itp[i] = rk++; }
        __syncthreads();
        if (tid < 256) { const int p = itp[tid]; slot[blk * 256 + tid] = p; rgate[p] = topg[blk * 256 + tid]; }
        for (int i = wave; i < 256; i += NWAVES) { const int p = itp[i]; const int row = blk * 64 + (i >> 2);
            const v4u* s = (const v4u*)(XN + (size_t)row * DM); v4u* d = (v4u*)(XS + (size_t)p * DM); d[lane] = s[lane]; d[lane + 64] = s[lane + 64]; }
        __syncthreads();
    }
}

__device__ __forceinline__ void p10_combine(const Args& a, int gw, int NGW, int lane) {
    const int* slot = (const int*)(a.ws + WS_RT + RT_SLOT); const bf16* Y = (const bf16*)(a.ws + WS_XS);
    for (int tok = gw; tok < NTOK; tok += NGW) {
        const int r0 = slot[tok * 4], r1 = slot[tok * 4 + 1], r2 = slot[tok * 4 + 2], r3 = slot[tok * 4 + 3];
        f32x4* o = (f32x4*)(a.out + (size_t)tok * DM) + lane;
#pragma unroll
        for (int j = 0; j < 4; ++j) { f32x4 v = o[64 * j];
            const v2u y0 = ((const v2u*)(Y + (size_t)r0 * DM))[64 * j + lane], y1 = ((const v2u*)(Y + (size_t)r1 * DM))[64 * j + lane], y2 = ((const v2u*)(Y + (size_t)r2 * DM))[64 * j + lane], y3 = ((const v2u*)(Y + (size_t)r3 * DM))[64 * j + lane];
            v.x += (bflo(y0.x) + bflo(y1.x)) + (bflo(y2.x) + bflo(y3.x)); v.y += (bfhi(y0.x) + bfhi(y1.x)) + (bfhi(y2.x) + bfhi(y3.x));
            v.z += (bflo(y0.y) + bflo(y1.y)) + (bflo(y2.y) + bflo(y3.y)); v.w += (bfhi(y0.y) + bfhi(y1.y)) + (bfhi(y2.y) + bfhi(y3.y));
            o[64 * j] = v; }
    }
}

__global__ void __launch_bounds__(NTHREADS, 2) mk_fwd(Args a) {
    extern __shared__ __attribute__((aligned(16))) unsigned char lds_raw[];
    LAS unsigned char* lds = (LAS unsigned char*)lds_raw;
    const int tid = threadIdx.x, lane = tid & 63, wave = __builtin_amdgcn_readfirstlane(tid >> 6);
    const int G = gridDim.x, bx = blockIdx.x;
    const int vcu = (G % 8 == 0) ? (bx % 8) * (G / 8) + bx / 8 : bx;
    const int gw = vcu * NWAVES + wave, NGW = G * NWAVES, gtid = bx * NTHREADS + tid, NGT = G * NTHREADS;
    unsigned* ctl = (unsigned*)(a.ws + WS_CTL);
    for (int u = tid; u < (LDS_BYTES - LDSCTL_OFF) / 4; u += NTHREADS) ((LAS unsigned*)(lds + LDSCTL_OFF))[u] = 0u;
    __syncthreads();
    XcdBarrier bar; bar.bar = ctl + CW_BAR; bar.x = 0; bar.st = nullptr;
    if (!MK_PER_PHASE) bar = xcd_barrier_post(ctl + CW_BAR, (volatile LAS unsigned*)(lds + MISC_OFF) + 8);
    const int lo = a.ph_lo, hi = a.ph_hi;
#ifndef PH_MASK
#define PH_MASK 0x7ff
#endif
#define IN(k) (((PH_MASK >> (k)) & 1) && lo <= (k) && (k) < hi)
#define SEAM(k) do { if (IN(k) && IN((k) + 1)) xcd_barrier(bar); } while (0)

    if (IN(0)) { p0_prologue(a, lds, gw, NGW, lane, wave); } SEAM(0);
    if (IN(1)) {
        pg8::Gemm g{(const pg8::bf16_t*)(a.ws + WS_XN), (const pg8::bf16_t*)(a.ws + WS_WIN), NTOK, INC, DM}; pg8::StaticOrder S; S.init(NTOK, INC, G, bx);
        pg8::EpiBf16<0> E{(pg8::bf16_t*)(a.ws + WS_PROJ), INC, nullptr, 0, 0, 1.f};
        pg8::gemm_phase<pg8::EpiBf16<0>, pg8::StaticOrder, true, true>(lds, g, S, E);
    } SEAM(1);
    if (IN(2)) { p2_qkprep(a, gtid, NGT); } SEAM(2);
    SEAM(3);
    if (IN(4)) { p4_hgrn_final(a, gw, NGW, lane); } SEAM(4);
    if (IN(5)) {
        pg8::Gemm g{(const pg8::bf16_t*)(a.ws + WS_MIX), (const pg8::bf16_t*)(a.ws + WS_WOUT), NTOK, DM, DM}; pg8::StaticOrder S; S.init(NTOK, DM, G, bx);
        pg8::EpiResF32 E{a.x, a.out, DM};
        pg8::gemm_phase<pg8::EpiResF32, pg8::StaticOrder, true, true>(lds, g, S, E);
    } SEAM(5);
    if (IN(6)) { p6_router(a, lds, tid, lane, wave); } SEAM(6);
    if (IN(7)) { p7_gather(a, lds, tid, lane, wave); } SEAM(7);
    if (IN(8)) {
        if (lo == 8) moe_tables(a, lds, tid, 0);
        const int ntiles = ((LAS int*)(lds + L_PADS))[32];
        pg8::Gemm g{(const pg8::bf16_t*)(a.ws + WS_XS), (const pg8::bf16_t*)(a.ws + WS_WUP), PMAX, 2048, DM};
        pg8::MoeOrder S{8, ntiles * 8, G, bx, (const LAS unsigned char*)(lds + L_TEXP)};
        pg8::EpiSwiglu E{(pg8::bf16_t*)(a.ws + WS_ACT), a.b_up};
        pg8::gemm_phase<pg8::EpiSwiglu, pg8::MoeOrder, true, true>(lds, g, S, E);
    } SEAM(8);
    if (IN(9)) {
        if (lo == 9) moe_tables(a, lds, tid, 0);
        const int ntiles = ((LAS int*)(lds + L_PADS))[32];
        pg8::Gemm g{(const pg8::bf16_t*)(a.ws + WS_ACT), (const pg8::bf16_t*)(a.ws + WS_WDN), PMAX, 1024, DM};
        pg8::MoeOrder S{4, ntiles * 4, G, bx, (const LAS unsigned char*)(lds + L_TEXP)};
        pg8::EpiDown E{(pg8::bf16_t*)(a.ws + WS_XS), a.b_dn, (const float*)(a.ws + WS_RT + RT_GATE)};
        pg8::gemm_phase<pg8::EpiDown, pg8::MoeOrder, true, true>(lds, g, S, E);
    } SEAM(9);
    if (IN(10)) { p10_combine(a, gw, NGW, lane); }
#undef IN
#undef SEAM
}

__global__ void __launch_bounds__(NTHREADS, 2) mk_naive3(Args a) {
    extern __shared__ __attribute__((aligned(16))) unsigned char lds_raw[];
    LAS unsigned char* lds = (LAS unsigned char*)lds_raw;
    const int tid = threadIdx.x, bx = blockIdx.x, gtid = bx * NTHREADS + tid, NGT = gridDim.x * NTHREADS;
    p3_attn_naive(a, gtid, NGT); if (bx < 4) p3_hgrn_naive(a, lds, tid);
}
extern "C" void kernel_launch(void* const* d_in, const int* in_sizes, int n_in, void* d_out, int out_size, void* d_ws, size_t ws_size, hipStream_t stream) {
    static int grid = 0;
    if (grid == 0) {
        if (n_in != 16 || in_sizes[0] != NTOK * DM || out_size != NTOK * DM || ws_size < WS_END) { fprintf(stderr, "kernel_launch: unexpected shapes / workspace (%d inputs, ws %zu)\n", n_in, ws_size); grid = -1; return; }
        int dev = 0, cus = 0;
        if (hipGetDevice(&dev) != hipSuccess || hipDeviceGetAttribute(&cus, hipDeviceAttributeMultiprocessorCount, dev) != hipSuccess) { grid = -1; return; }
        if (hipFuncSetAttribute((const void*)mk_fwd, hipFuncAttributeMaxDynamicSharedMemorySize, LDS_BYTES) != hipSuccess || hipFuncSetAttribute((const void*)mk_naive3, hipFuncAttributeMaxDynamicSharedMemorySize, LDS_BYTES) != hipSuccess) { fprintf(stderr, "kernel_launch: hipFuncSetAttribute failed\n"); grid = -1; return; }
        (void)hipGetLastError();
        grid = cus;
    }
    if (grid < 0) return;
    if (hipMemsetAsync((char*)d_ws + WS_CTL, 0, CTL_ZERO_BYTES, stream) != hipSuccess) return;
    Args a{};
    a.x = (const float*)d_in[0]; a.pos = (const int*)d_in[1]; a.g1 = (const float*)d_in[2]; a.w_in = (const float*)d_in[3]; a.qg = (const float*)d_in[4]; a.kg = (const float*)d_in[5];
    a.lb = (const float*)d_in[6]; a.og = (const float*)d_in[7]; a.w_out = (const float*)d_in[8]; a.g2 = (const float*)d_in[9]; a.w_r = (const float*)d_in[10]; a.b_r = (const float*)d_in[11];
    a.w_up = (const float*)d_in[12]; a.b_up = (const float*)d_in[13]; a.w_dn = (const float*)d_in[14]; a.b_dn = (const float*)d_in[15];
    a.out = (float*)d_out; a.ws = (unsigned char*)d_ws;
#if MK_PER_PHASE
    for (int p = 0; p < NPHASE; ++p) { a.ph_lo = p; a.ph_hi = p + 1;
        if (p == 3) hipLaunchKernelGGL(mk_naive3, dim3(grid), dim3(NTHREADS), LDS_BYTES, stream, a);
        else hipLaunchKernelGGL(mk_fwd, dim3(grid), dim3(NTHREADS), LDS_BYTES, stream, a); }
#else
    a.ph_lo = 0; a.ph_hi = NPHASE; hipLaunchKernelGGL(mk_fwd, dim3(grid), dim3(NTHREADS), LDS_BYTES, stream, a);
#endif
}
```

```cpp
#include <hip/hip_runtime.h>
#include <cstdio>
#include <cstdint>
namespace pg8 {
#define PG8_LAS __attribute__((address_space(3)))
typedef unsigned short bf16_t;
typedef short bf16x8 __attribute__((ext_vector_type(8)));
typedef float f32x4 __attribute__((ext_vector_type(4)));
typedef unsigned u32x4 __attribute__((ext_vector_type(4)));
constexpr int BM = 256, BK = 64, HALF = 128, HTB = HALF * BK * 2  , STAGE_BYTES = 8 * HTB, NXCD = 8, WGM = 8;

__host__ __device__ __forceinline__ int lds_byte(int r, int c) { const int st = (r >> 4) * 2 + (c >> 5), rr = r & 15, cc = c & 31, ob = rr * 64 + cc * 2; return st * 1024 + (ob ^ (((ob >> 9) & 1) << 5)); }
__host__ __device__ __forceinline__ void stage_rc(int b, int& R, int& C) { const int st = b / 1024, sb = b % 1024, swz = sb ^ (((sb >> 9) & 1) << 5); R = (st >> 1) * 16 + swz / 64; C = (st & 1) * 32 + (swz % 64) / 2; }
__host__ __device__ __forceinline__ int perm32(int rho) { const int n = rho >> 4, i = rho & 15; return 8 * (i >> 2) + 4 * n + (i & 3); }

struct Unit { int pm, pn; };
struct Gemm { const bf16_t* A; const bf16_t* Bt; int M, N, K; };

struct StaticOrder {
    int nM, nN, nwg, G, c;
    __host__ __device__ void init(int M, int N, int G_, int c_) { nM = M / BM; nN = N / BM; nwg = nM * nN; G = G_; c = c_; }
    __host__ __device__ bool next(int i, Unit& u) const {
        const long L = (long)i * G + c; if (L >= nwg) return false;
        int wgid = (int)L; { const int q = nwg / NXCD, r = nwg % NXCD, xcd = wgid % NXCD, off = wgid / NXCD; wgid = (xcd < r ? xcd * (q + 1) : r * (q + 1) + (xcd - r) * q) + off; }
        const int nig = WGM * nN, gid = wgid / nig, fm = gid * WGM, gsz = (nM - fm) < WGM ? (nM - fm) : WGM;
        u.pm = fm + ((wgid % nig) % gsz); u.pn = (wgid % nig) / gsz; return true;
    }
    __device__ __forceinline__ void a_ready(const Unit&) const {}
    __device__ __forceinline__ void done(const Unit&) const {}
};

__device__ __forceinline__ unsigned cvt_pk_bf16(float lo, float hi) { unsigned r; asm volatile("v_cvt_pk_bf16_f32 %0, %1, %2" : "=v"(r) : "v"(lo), "v"(hi)); return r; }
typedef float f32x2 __attribute__((ext_vector_type(2)));
__device__ __forceinline__ f32x2 gelu_pk(f32x2 v) {
    const f32x2 av = __builtin_elementwise_abs(v), d = av * 0.2316418882f + 1.0f;
    f32x2 t; t.x = __builtin_amdgcn_rcpf(d.x); t.y = __builtin_amdgcn_rcpf(d.y);
    f32x2 q = t * 0.5307027145f + (-0.7265760135f); q = q * t + 0.7107068705f; q = q * t + (-0.142248368f); q = q * t + 0.127414796f; q = q * t;
    const f32x2 s = (v * v) * (-0.72134752044f);
    f32x2 e; e.x = __builtin_amdgcn_exp2f(s.x); e.y = __builtin_amdgcn_exp2f(s.y);
    const f32x2 m = v * (q * e), r = v - m;
    f32x2 o; o.x = v.x < 0.f ? m.x : r.x; o.y = v.y < 0.f ? m.y : r.y; return o;
}

template <int ACT  > struct EpiBf16 {
    static constexpr bool PERM = true, AFTER_DRAIN = false; static_assert(ACT == 0 || ACT == 1, "EpiBf16: ACT is 0 (none) or 1 (gelu_pk)");
    bf16_t* O; int ldc; const float* bias; int split_cols; size_t split_stride; float scale0;
    __device__ __forceinline__ void operator()(const f32x4 (&acc)[2][2][4][2], const Unit& u, int wr, int wc, int fr, int fq) const {
        const int row0 = u.pm * BM + wr * 64 + fr; int colt = u.pn * BM; bf16_t* base = O;
        float sc = 1.f; if (split_cols) { const int t = colt / split_cols; base += (size_t)t * split_stride; colt -= t * split_cols; if (t == 0) sc = scale0; }
        const int col0 = colt + wc * 32 + 8 * fq, bcol0 = u.pn * BM + wc * 32 + 8 * fq;
        f32x4 bv[2][2];
#pragma unroll
        for (int bj = 0; bj < 2; ++bj)
#pragma unroll
            for (int n = 0; n < 2; ++n) bv[bj][n] = bias ? *(const f32x4*)(bias + bcol0 + bj * HALF + 4 * n) : (f32x4){0.f, 0.f, 0.f, 0.f};
#pragma unroll
        for (int ai = 0; ai < 2; ++ai)
#pragma unroll
            for (int m = 0; m < 4; ++m) { bf16_t* rowp = base + (size_t)(row0 + ai * HALF + m * 16) * ldc + col0;
#pragma unroll
                for (int bj = 0; bj < 2; ++bj) { f32x4 v0 = acc[ai][bj][m][0] + bv[bj][0], v1 = acc[ai][bj][m][1] + bv[bj][1];
                    if (ACT == 1) { f32x2 a = gelu_pk((f32x2){v0[0], v0[1]}), b = gelu_pk((f32x2){v0[2], v0[3]}), c = gelu_pk((f32x2){v1[0], v1[1]}), d = gelu_pk((f32x2){v1[2], v1[3]});
                        v0 = (f32x4){a.x, a.y, b.x, b.y}; v1 = (f32x4){c.x, c.y, d.x, d.y}; }
                    v0 = v0 * sc; v1 = v1 * sc; u32x4 w; w.x = cvt_pk_bf16(v0[0], v0[1]); w.y = cvt_pk_bf16(v0[2], v0[3]); w.z = cvt_pk_bf16(v1[0], v1[1]); w.w = cvt_pk_bf16(v1[2], v1[3]);
                    *(u32x4*)(rowp + bj * HALF) = w; } }
    }
};

struct EpiResF32 {
    static constexpr bool PERM = false, AFTER_DRAIN = false;
    const float* base; float* out; int ldc;
    __device__ __forceinline__ void operator()(const f32x4 (&acc)[2][2][4][2], const Unit& u, int wr, int wc, int fr, int fq) const {
        const int row0 = u.pm * BM + wr * 64 + fr, col0 = u.pn * BM + wc * 32 + 4 * fq;
#pragma unroll
        for (int ai = 0; ai < 2; ++ai)
#pragma unroll
            for (int m = 0; m < 4; ++m) { const size_t off = (size_t)(row0 + ai * HALF + m * 16) * ldc + col0;
#pragma unroll
                for (int bj = 0; bj < 2; ++bj)
#pragma unroll
                    for (int n = 0; n < 2; ++n) *(f32x4*)(out + off + bj * HALF + n * 16) = *(const f32x4*)(base + off + bj * HALF + n * 16) + acc[ai][bj][m][n]; }
    }
};
__device__ __forceinline__ float sigmoid_fast(float x) { return __builtin_amdgcn_rcpf(1.0f + __builtin_amdgcn_exp2f(-1.4426950408889634f * x)); }
struct EpiSwiglu {
    static constexpr bool PERM = true, AFTER_DRAIN = false;
    bf16_t* ACT; const float* b_up;
    __device__ __forceinline__ void operator()(const f32x4 (&acc)[2][2][4][2], const Unit& u, int wr, int wc, int fr, int fq) const {
        const int e = u.pn >> 3, pnl = u.pn & 7;
        const int row0 = u.pm * BM + wr * 64 + fr, j0 = pnl * 128 + wc * 32 + 8 * fq;
        const float* bp = b_up + (size_t)e * 2048 + 2 * j0;
        const f32x4 b0 = *(const f32x4*)(bp), b1 = *(const f32x4*)(bp + 4), b2 = *(const f32x4*)(bp + 8), b3 = *(const f32x4*)(bp + 12);
        const float bg[8] = {b0[0], b0[2], b1[0], b1[2], b2[0], b2[2], b3[0], b3[2]};
        const float bl[8] = {b0[1], b0[3], b1[1], b1[3], b2[1], b2[3], b3[1], b3[3]};
#pragma unroll
        for (int ai = 0; ai < 2; ++ai)
#pragma unroll
            for (int m = 0; m < 4; ++m) {
                float o[8];
#pragma unroll
                for (int n = 0; n < 2; ++n)
#pragma unroll
                    for (int i = 0; i < 4; ++i) {
                        float g = acc[ai][0][m][n][i] + bg[4 * n + i], l = acc[ai][1][m][n][i] + bl[4 * n + i];
                        g = fminf(g, 7.0f); l = fminf(fmaxf(l, -7.0f), 7.0f);
                        o[4 * n + i] = g * sigmoid_fast(1.702f * g) * (l + 1.0f);
                    }
                u32x4 w; w.x = cvt_pk_bf16(o[0], o[1]); w.y = cvt_pk_bf16(o[2], o[3]); w.z = cvt_pk_bf16(o[4], o[5]); w.w = cvt_pk_bf16(o[6], o[7]);
                *(u32x4*)(ACT + (size_t)(row0 + ai * HALF + m * 16) * 1024 + j0) = w;
            }
    }
};
struct EpiDown {
    static constexpr bool PERM = true, AFTER_DRAIN = false;
    bf16_t* Y; const float* b_down; const float* row_gate;
    __device__ __forceinline__ void operator()(const f32x4 (&acc)[2][2][4][2], const Unit& u, int wr, int wc, int fr, int fq) const {
        const int e = u.pn >> 2, pnl = u.pn & 3;
        const int row0 = u.pm * BM + wr * 64 + fr, col0 = pnl * BM + wc * 32 + 8 * fq;
        f32x4 bv[2][2];
#pragma unroll
        for (int bj = 0; bj < 2; ++bj)
#pragma unroll
            for (int n = 0; n < 2; ++n) bv[bj][n] = *(const f32x4*)(b_down + (size_t)e * 1024 + col0 + bj * HALF + 4 * n);
#pragma unroll
        for (int ai = 0; ai < 2; ++ai)
#pragma unroll
            for (int m = 0; m < 4; ++m) { const int row = row0 + ai * HALF + m * 16; const float gt = row_gate[row];
#pragma unroll
                for (int bj = 0; bj < 2; ++bj) { const f32x4 v0 = (acc[ai][bj][m][0] + bv[bj][0]) * gt, v1 = (acc[ai][bj][m][1] + bv[bj][1]) * gt;
                    u32x4 w; w.x = cvt_pk_bf16(v0[0], v0[1]); w.y = cvt_pk_bf16(v0[2], v0[3]); w.z = cvt_pk_bf16(v1[0], v1[1]); w.w = cvt_pk_bf16(v1[2], v1[3]);
                    *(u32x4*)(Y + (size_t)row * 1024 + col0 + bj * HALF) = w; } }
    }
};
struct MoeOrder {
    int nNl, nunits, G, c; const PG8_LAS unsigned char* texp;
    __device__ __forceinline__ bool next(int i, Unit& u) const {
        const long L = (long)i * G + c; if (L >= nunits) return false;
        int wgid = (int)L; { const int q = nunits / NXCD, r = nunits % NXCD, xcd = wgid % NXCD, off = wgid / NXCD; wgid = (xcd < r ? xcd * (q + 1) : r * (q + 1) + (xcd - r) * q) + off; }
        const int rt = wgid / nNl, pnl = wgid - rt * nNl;
        u.pm = rt; u.pn = (int)texp[rt] * nNl + pnl; return true;
    }
    __device__ __forceinline__ void a_ready(const Unit&) const {}
    __device__ __forceinline__ void done(const Unit&) const {}
};
template <class Epi, class Sched, bool ALIGN_EPI = false, bool SP2 = false>
__device__ __forceinline__ void gemm_phase(PG8_LAS unsigned char* lds, const Gemm g, const Sched& S, const Epi& E) {
    const int tid = threadIdx.x, wid = __builtin_amdgcn_readfirstlane(tid >> 6), lane = tid & 63, wr = wid >> 2, wc = wid & 3, fr = lane & 15, fq = lane >> 4;
    const int K = g.K, nt = K / BK;
    unsigned voffA[2], voffB[2];
#pragma unroll
    for (int i = 0; i < 2; ++i) { int R, C; stage_rc(tid * 16 + i * 8192, R, C); const int Rb = Epi::PERM ? ((R & ~31) + perm32(R & 31)) : R;
        voffA[i] = (unsigned)(R * K + C) * 2u; voffB[i] = (unsigned)(Rb * K + C) * 2u; }
    const size_t kstep = (size_t)(BK * 2);
    const size_t hstep = (size_t)HALF * K * 2;
    const size_t tstep = 2 * hstep;
    const unsigned ldsw = (unsigned)wid * 1024u;
    const int aoff = lds_byte(wr * 64 + fr, fq * 8), boff = lds_byte(wc * 32 + fr, fq * 8);
#define PG8_SA(b, h) (((b) * 2 + (h)) * HTB)
#define PG8_SB(b, h) ((4 + (b) * 2 + (h)) * HTB)
#define PG8_STAGE(bufoff, gbase, voff) do { _Pragma("unroll") for (int _i = 0; _i < 2; ++_i) \
        __builtin_amdgcn_global_load_lds((const unsigned*)((const char*)(gbase) + (voff)[_i]), (PG8_LAS unsigned*)(lds + (bufoff) + ldsw + _i * 8192), 16, 0, 0); } while (0)
#define PG8_LDA(dst, b, h) do { _Pragma("unroll") for (int m = 0; m < 4; ++m) _Pragma("unroll") for (int k = 0; k < 2; ++k) dst[m][k] = *(const PG8_LAS bf16x8*)(lds + PG8_SA(b, h) + aoff + m * 2048 + k * 1024); } while (0)
#define PG8_LDB(dst, b, h) do { _Pragma("unroll") for (int n = 0; n < 2; ++n) _Pragma("unroll") for (int k = 0; k < 2; ++k) dst[n][k] = *(const PG8_LAS bf16x8*)(lds + PG8_SB(b, h) + boff + n * 2048 + k * 1024); } while (0)
#define PG8_MMA(ai, bj, At, Bt) do { __builtin_amdgcn_s_setprio(1); _Pragma("unroll") for (int m = 0; m < 4; ++m) _Pragma("unroll") for (int n = 0; n < 2; ++n) _Pragma("unroll") for (int k = 0; k < 2; ++k) \
        acc[ai][bj][m][n] = __builtin_amdgcn_mfma_f32_16x16x32_bf16(Bt[n][k], At[m][k], acc[ai][bj][m][n], 0, 0, 0); __builtin_amdgcn_s_setprio(0); } while (0)
#define PG8_WAIT_V(n) asm volatile("s_waitcnt vmcnt(" #n ")" ::: "memory")
#define PG8_WAIT_L(n) asm volatile("s_waitcnt lgkmcnt(" #n ")" ::: "memory")
#define PG8_BAR __builtin_amdgcn_s_barrier()
#define PG8_SCHED __builtin_amdgcn_sched_barrier(0)
    Unit cur, nxt; int ui = 0;
    if (!S.next(0, cur)) return;
    f32x4 acc[2][2][4][2];
#pragma unroll
    for (int a = 0; a < 2; ++a)
#pragma unroll
        for (int b = 0; b < 2; ++b)
#pragma unroll
            for (int m = 0; m < 4; ++m)
#pragma unroll
                for (int n = 0; n < 2; ++n) acc[a][b][m][n] = (f32x4){0.f, 0.f, 0.f, 0.f};
    bf16x8 At[4][2], B0[2][2], B1[2][2];
    const char* cA = (const char*)g.A + (size_t)cur.pm * tstep; const char* cB = (const char*)g.Bt + (size_t)cur.pn * tstep;
    S.a_ready(cur);
    if constexpr (SP2) {
        PG8_STAGE(PG8_SB(0, 0), cB, voffB); PG8_STAGE(PG8_SB(0, 1), cB + hstep, voffB); PG8_STAGE(PG8_SA(0, 0), cA, voffA); PG8_STAGE(PG8_SA(0, 1), cA + hstep, voffA);
        if (wr == 1) PG8_BAR;
        PG8_WAIT_V(2); PG8_BAR;
        PG8_STAGE(PG8_SB(1, 0), cB + kstep, voffB); PG8_STAGE(PG8_SA(1, 0), cA + kstep, voffA); PG8_STAGE(PG8_SB(1, 1), cB + hstep + kstep, voffB);
        PG8_WAIT_V(6); PG8_BAR;
    } else {
        PG8_STAGE(PG8_SB(0, 0), cB, voffB); PG8_STAGE(PG8_SA(0, 0), cA, voffA); PG8_STAGE(PG8_SB(0, 1), cB + hstep, voffB); PG8_STAGE(PG8_SA(0, 1), cA + hstep, voffA);
        if (wr == 1) PG8_BAR;
        PG8_WAIT_V(4); PG8_BAR;
        PG8_STAGE(PG8_SB(1, 0), cB + kstep, voffB); PG8_STAGE(PG8_SA(1, 0), cA + kstep, voffA); PG8_STAGE(PG8_SB(1, 1), cB + hstep + kstep, voffB);
        PG8_WAIT_V(6); PG8_BAR;
    }
    for (;;) {
        const bool has_next = S.next(ui + 1, nxt);
        const char* nA = has_next ? (const char*)g.A + (size_t)nxt.pm * tstep : cA; const char* nB = has_next ? (const char*)g.Bt + (size_t)nxt.pn * tstep : cB;
        for (int t = 0; t < nt; t += 2) {
            const bool last = (t == nt - 2);
            const char* a1 = cA + (size_t)(t + 1) * kstep;
            const char* a2 = last ? nA : cA + (size_t)(t + 2) * kstep; const char* b2 = last ? nB : cB + (size_t)(t + 2) * kstep;
            const char* a3 = a2 + kstep; const char* b3 = b2 + kstep;
            if (last && has_next) S.a_ready(nxt);
            if constexpr (SP2) {
            PG8_LDB(B0, 0, 0); PG8_LDB(B1, 0, 1); PG8_SCHED; PG8_LDA(At, 0, 0); PG8_STAGE(PG8_SA(1, 1), a1 + hstep, voffA);
            PG8_WAIT_V(8); PG8_WAIT_L(0); PG8_BAR; PG8_MMA(0, 0, At, B0); PG8_MMA(0, 1, At, B1); PG8_BAR; PG8_SCHED;
            PG8_LDA(At, 0, 1); PG8_STAGE(PG8_SB(0, 0), b2, voffB); PG8_STAGE(PG8_SB(0, 1), b2 + hstep, voffB); PG8_STAGE(PG8_SA(0, 0), a2, voffA);
            PG8_WAIT_V(8); PG8_WAIT_L(0); PG8_BAR; PG8_MMA(1, 0, At, B0); PG8_MMA(1, 1, At, B1); PG8_BAR; PG8_SCHED;
            PG8_LDB(B0, 1, 0); PG8_LDB(B1, 1, 1); PG8_SCHED; PG8_LDA(At, 1, 0); PG8_STAGE(PG8_SA(0, 1), a2 + hstep, voffA);
            PG8_WAIT_V(8); PG8_WAIT_L(0); PG8_BAR; PG8_MMA(0, 0, At, B0); PG8_MMA(0, 1, At, B1); PG8_BAR; PG8_SCHED;
            PG8_LDA(At, 1, 1); PG8_STAGE(PG8_SB(1, 0), b3, voffB); PG8_STAGE(PG8_SB(1, 1), b3 + hstep, voffB); PG8_STAGE(PG8_SA(1, 0), a3, voffA);
            PG8_WAIT_V(8); PG8_WAIT_L(0); PG8_BAR; PG8_MMA(1, 0, At, B0); PG8_MMA(1, 1, At, B1); PG8_BAR; PG8_SCHED;
            } else {
            PG8_LDB(B0, 0, 0); PG8_SCHED; PG8_LDA(At, 0, 0); PG8_STAGE(PG8_SA(1, 1), a1 + hstep, voffA);
            PG8_WAIT_L(8); PG8_BAR; PG8_WAIT_L(0); PG8_MMA(0, 0, At, B0); PG8_BAR; PG8_SCHED;
            PG8_LDB(B1, 0, 1); PG8_STAGE(PG8_SB(0, 0), b2, voffB);
            PG8_BAR; PG8_WAIT_L(0); PG8_MMA(0, 1, At, B1); PG8_BAR;
            PG8_LDA(At, 0, 1); PG8_STAGE(PG8_SA(0, 0), a2, voffA);
            PG8_BAR; PG8_WAIT_L(0); PG8_MMA(1, 0, At, B0); PG8_BAR; PG8_SCHED;
            PG8_STAGE(PG8_SB(0, 1), b2 + hstep, voffB);
            PG8_WAIT_V(6); PG8_BAR; PG8_MMA(1, 1, At, B1); PG8_BAR;
            PG8_LDB(B0, 1, 0); PG8_SCHED; PG8_LDA(At, 1, 0); PG8_STAGE(PG8_SA(0, 1), a2 + hstep, voffA);
            PG8_WAIT_L(8); PG8_BAR; PG8_WAIT_L(0); PG8_MMA(0, 0, At, B0); PG8_BAR; PG8_SCHED;
            PG8_LDB(B1, 1, 1); PG8_STAGE(PG8_SB(1, 0), b3, voffB);
            PG8_BAR; PG8_WAIT_L(0); PG8_MMA(0, 1, At, B1); PG8_BAR;
            PG8_LDA(At, 1, 1); PG8_STAGE(PG8_SA(1, 0), a3, voffA);
            PG8_BAR; PG8_WAIT_L(0); PG8_MMA(1, 0, At, B0); PG8_BAR; PG8_SCHED;
            PG8_STAGE(PG8_SB(1, 1), b3 + hstep, voffB);
            PG8_WAIT_V(6); PG8_BAR; PG8_MMA(1, 1, At, B1); PG8_BAR;
            }
        }
        if constexpr (ALIGN_EPI) { if (wr == 0) PG8_BAR; }
        if constexpr (!Epi::AFTER_DRAIN) { E(acc, cur, wr, wc, fr, fq); S.done(cur); }
        if (!has_next) break;
#pragma unroll
        for (int a = 0; a < 2; ++a)
#pragma unroll
            for (int b = 0; b < 2; ++b)
#pragma unroll
                for (int m = 0; m < 4; ++m)
#pragma unroll
                    for (int n = 0; n < 2; ++n) acc[a][b][m][n] = (f32x4){0.f, 0.f, 0.f, 0.f};
        cur = nxt; cA = nA; cB = nB; ++ui;
        if constexpr (ALIGN_EPI) { if (wr == 1) PG8_BAR; }
    }
    PG8_WAIT_V(0);
    if constexpr (!ALIGN_EPI) { if (wr == 0) PG8_BAR; }
    PG8_BAR;
    if constexpr (Epi::AFTER_DRAIN) { E.fused(acc, cur, wr, wc, fr, fq, lds, wid, lane); S.done(cur); }
#undef PG8_SA
#undef PG8_SB
#undef PG8_STAGE
#undef PG8_LDA
#undef PG8_LDB
#undef PG8_MMA
#undef PG8_WAIT_V
#undef PG8_WAIT_L
#undef PG8_BAR
#undef PG8_SCHED
}
}

constexpr int NWAVES = 8, NTHREADS = 512;
constexpr int BATCH = 2, SEQ = 8192, NTOK = BATCH * SEQ, DM = 1024, INC = 4096;
constexpr int NE = 32, TOPK = 4;
constexpr int PMAX = NTOK * TOPK + NE * 256;
constexpr int MAXTILES = PMAX / 256;
constexpr float EPS = 1e-6f;
constexpr int C_HQ = 0, C_HFF = 512, C_HFB = 1024, C_HI = 1536, C_HG = 2048, C_AQ = 2560, C_AK = 3072, C_AV = 3584;

#ifndef MK_PER_PHASE
#define MK_PER_PHASE 0
#endif
constexpr int NPHASE = 12;
#ifndef HGRN_CHUNK
#define HGRN_CHUNK 1
#endif

constexpr size_t MiB = 1u << 20;
constexpr size_t WS_CTL = 0, CTL_ZERO_BYTES = 1 * MiB;
constexpr size_t WS_WIN = 2 * MiB, WS_WOUT = 10 * MiB, WS_WUP = 12 * MiB, WS_WDN = 140 * MiB;
constexpr size_t WS_XN = 204 * MiB, WS_PROJ = 236 * MiB, WS_CS = 364 * MiB, WS_QR = 368 * MiB, WS_KR = 384 * MiB;
constexpr size_t WS_MIX = 400 * MiB, WS_OF = 432 * MiB, WS_RT = 496 * MiB, WS_XS = 498 * MiB, WS_ACT = 642 * MiB, WS_END = 786 * MiB;
constexpr size_t RT_TOPE = 0, RT_TOPG = 256 * 1024, RT_SLOT = 512 * 1024, RT_HIST = 768 * 1024, RT_GATE = 1024 * 1024;
constexpr int CW_TMO = 0, CW_BAR = 4096;

constexpr int RING_BYTES = 131072;
constexpr int LDSCTL_OFF = RING_BYTES;
constexpr int MISC_OFF = LDSCTL_OFF;
constexpr int L_HIST = LDSCTL_OFF + 256;
constexpr int L_TOT = L_HIST + 128;
constexpr int L_MINE = L_TOT + 128;
constexpr int L_PADS = L_MINE + 128;
constexpr int L_TEXP = L_PADS + 256;
constexpr int L_ITE = L_TEXP + 512;
constexpr int L_ITP = L_ITE + 1024;
constexpr int L_HG = L_ITP + 1024;
constexpr int LDS_BYTES = 147456;
static_assert(L_HG + 12288 <= LDS_BYTES, "LDS map");

#define GAS __attribute__((address_space(1)))
#define LAS __attribute__((address_space(3)))
typedef unsigned short bf16;
typedef unsigned v4u __attribute__((ext_vector_type(4)));
typedef unsigned v2u __attribute__((ext_vector_type(2)));
typedef float f32x4 __attribute__((ext_vector_type(4)));
typedef GAS unsigned gu32;
#define RLX_AGENT __ATOMIC_RELAXED, __HIP_MEMORY_SCOPE_AGENT
#define LDS_WAIT() asm volatile("s_waitcnt lgkmcnt(0)" ::: "memory")
#define VM_WAIT() asm volatile("s_waitcnt vmcnt(0)" ::: "memory")
__device__ __forceinline__ unsigned f2bf(float f) { unsigned u = __builtin_bit_cast(unsigned, f); return (u + 0x7fffu + ((u >> 16) & 1u)) >> 16; }
__device__ __forceinline__ unsigned pk2(float lo, float hi) { return f2bf(lo) | (f2bf(hi) << 16); }
__device__ __forceinline__ float bf2f(unsigned b) { return __builtin_bit_cast(float, b << 16); }
__device__ __forceinline__ float bflo(unsigned w) { return __builtin_bit_cast(float, w << 16); }
__device__ __forceinline__ float bfhi(unsigned w) { return __builtin_bit_cast(float, w & 0xffff0000u); }
__device__ __forceinline__ float sigm(float x) { return 1.0f / (1.0f + __expf(-x)); }

#define XB_TMO      128
#define XB_XCNT(j)  (256  + 64 * (j))
#define XB_XSUB(j)  (1280 + 64 * (j))
#define XB_XGEN(j)  (2304 + 64 * (j))
#define XB_TOP      3328
#define XB_TOPGEN   3392
#define XCD_BAR_WORDS 3456
#define XB_SPIN_CAP (1u << 23)
__device__ __forceinline__ unsigned xb_ld(unsigned* p)              { return __hip_atomic_load(p, __ATOMIC_RELAXED, __HIP_MEMORY_SCOPE_AGENT); }
__device__ __forceinline__ unsigned xb_add(unsigned* p, unsigned v) { return __hip_atomic_fetch_add(p, v, __ATOMIC_RELAXED, __HIP_MEMORY_SCOPE_AGENT); }
__device__ __forceinline__ unsigned xb_xcc_id() { return (unsigned)__builtin_amdgcn_s_getreg((3 << 11) | 20) & 0xFu; }
#define XB_SPIN(cond, bar) do { unsigned _sp = 0; while (cond) { __builtin_amdgcn_s_sleep(1); \
    if ((++_sp & 255u) == 0u) { if (xb_ld(&(bar)[XB_TMO])) break; if (_sp > XB_SPIN_CAP) { atomicAdd(&(bar)[XB_TMO], 1u); break; } } } } while (0)
struct XcdBarrier { unsigned* bar; unsigned x; volatile LAS unsigned* st; };
__device__ __forceinline__ XcdBarrier xcd_barrier_post(unsigned* bar, volatile LAS unsigned* st) {
    XcdBarrier b; b.bar = bar; b.x = xb_xcc_id(); b.st = st;
    if (threadIdx.x == 0) (void)xb_add(&bar[XB_XCNT(b.x)], 1u);
    return b;
}
__device__ __forceinline__ void xcd_barrier_complete(unsigned* bar, unsigned x, unsigned& nloc, unsigned& nx) {
    const unsigned G = gridDim.x * gridDim.y * gridDim.z;
    unsigned sum, cnt, mine, sp = 0u;
    for (;;) {
        sum = 0u; cnt = 0u; mine = 0u;
#pragma unroll
        for (unsigned j = 0; j < 16; ++j) { const unsigned c = xb_ld(&bar[XB_XCNT(j)]); sum += c; cnt += (c > 0u) ? 1u : 0u; mine = (j == x) ? c : mine; }
        if (sum == G) break;
        __builtin_amdgcn_s_sleep(1);
        if ((++sp & 255u) == 0u) { if (xb_ld(&bar[XB_TMO])) break; if (sp > XB_SPIN_CAP) { atomicAdd(&bar[XB_TMO], 1u); break; } }
    }
    nloc = mine > 0u ? mine : 1u; nx = cnt > 0u ? cnt : 1u;
}
__device__ __forceinline__ void xcd_barrier(const XcdBarrier& b) {
    asm volatile("s_waitcnt vmcnt(0)" ::: "memory");
    __syncthreads();
    if (threadIdx.x == 0) {
        unsigned* bar = b.bar;
        __builtin_amdgcn_s_waitcnt(0);
        unsigned nloc = b.st[0], nx = b.st[1];
        if (nloc == 0u) { xcd_barrier_complete(bar, b.x, nloc, nx); b.st[0] = nloc; b.st[1] = nx; }
        const unsigned old = xb_add(&bar[XB_XSUB(b.x)], 1u);
        const unsigned gen = old / nloc;
        if (old + 1u == (gen + 1u) * nloc) {
            __builtin_amdgcn_fence(__ATOMIC_RELEASE, "agent");
            asm volatile("s_waitcnt vmcnt(0)" ::: "memory");
            const unsigned og = xb_add(&bar[XB_TOP], 1u);
            const unsigned tg = og / nx;
            if (og + 1u == (tg + 1u) * nx) xb_add(&bar[XB_TOPGEN], 1u);
            else XB_SPIN(xb_ld(&bar[XB_TOPGEN]) == tg, bar);
            __builtin_amdgcn_fence(__ATOMIC_ACQUIRE, "agent");
            xb_add(&bar[XB_XGEN(b.x)], 1u);
            asm volatile("s_waitcnt vmcnt(0)" ::: "memory");
        } else {
            XB_SPIN(xb_ld(&bar[XB_XGEN(b.x)]) == gen, bar);
            __builtin_amdgcn_fence(__ATOMIC_ACQUIRE, "agent");
            asm volatile("s_waitcnt vmcnt(0)" ::: "memory");
        }
    }
    __syncthreads();
}

__device__ __forceinline__ float wave_sum(float v) {
#pragma unroll
    for (int o = 1; o < 64; o <<= 1) v += __shfl_xor(v, o);
    return v;
}

struct Args {
    const float* x; const int* pos; const float* g1; const float* w_in; const float* qg; const float* kg; const float* lb; const float* og;
    const float* w_out; const float* g2; const float* w_r; const float* b_r; const float* w_up; const float* b_up; const float* w_dn; const float* b_dn;
    float* out; unsigned char* ws; int ph_lo, ph_hi;
};

__device__ __forceinline__ void p0_item(const float* W, int K, int N, bf16* WTrow0, int k0, int src_col0, int src_stride, LAS float* scr, int lane) {
#pragma unroll 8
    for (int i = 0; i < 32; ++i) { const int kk = 2 * i + (lane >> 5); scr[kk * 33 + (lane & 31)] = W[(size_t)(k0 + kk) * N + src_col0 + src_stride * (lane & 31)]; }
    LDS_WAIT(); asm volatile("" ::: "memory");
    const int c = lane & 7;
#pragma unroll
    for (int j = 0; j < 4; ++j) { const int n = (lane >> 3) + 8 * j; const LAS float* s = scr + (8 * c) * 33 + n;
        v4u o; o.x = pk2(s[0 * 33], s[1 * 33]); o.y = pk2(s[2 * 33], s[3 * 33]); o.z = pk2(s[4 * 33], s[5 * 33]); o.w = pk2(s[6 * 33], s[7 * 33]);
        *(GAS v4u*)(WTrow0 + (size_t)n * K + k0 + 8 * c) = o; }
    LDS_WAIT(); asm volatile("" ::: "memory");
}
__device__ __forceinline__ void p0_prologue(const Args& a, LAS unsigned char* lds, int gw, int NGW, int lane, int wave) {
    LAS float* scr = (LAS float*)(lds + wave * 16384);
    bf16* Win_t = (bf16*)(a.ws + WS_WIN); bf16* Wout_t = (bf16*)(a.ws + WS_WOUT); bf16* Wup_t = (bf16*)(a.ws + WS_WUP); bf16* Wdn_t = (bf16*)(a.ws + WS_WDN);
    constexpr int I_UP = NE * 16 * 64, I_DN = NE * 16 * 32, I_IN = 16 * 128, I_OUT = 16 * 32;
    constexpr int NITEMS = I_UP + I_DN + I_IN + I_OUT;
    for (int it = gw; it < NITEMS; it += NGW) {
        int r = it;
        if (r < I_UP) { const int e = r >> 10; r &= 1023; const int kb = r >> 6, q = r & 63, p = q & 1, j0 = (q >> 1) * 32;
            const int c0 = 256 * (j0 >> 7) + 128 * p + (j0 & 127);
            p0_item(a.w_up + (size_t)e * 1024 * 2048, 1024, 2048, Wup_t + ((size_t)e * 2048 + c0) * 1024, kb * 64, 2 * j0 + p, 2, scr, lane); continue; }
        r -= I_UP;
        if (r < I_DN) { const int e = r >> 9; r &= 511; const int kb = r >> 5, nb = r & 31;
            p0_item(a.w_dn + (size_t)e * 1024 * 1024, 1024, 1024, Wdn_t + ((size_t)e * 1024 + nb * 32) * 1024, kb * 64, nb * 32, 1, scr, lane); continue; }
        r -= I_DN;
        if (r < I_IN) { const int kb = r >> 7, nb = r & 127;
            p0_item(a.w_in, 1024, INC, Win_t + (size_t)(nb * 32) * 1024, kb * 64, nb * 32, 1, scr, lane); continue; }
        r -= I_IN;
        { const int kb = r >> 5, nb = r & 31;
            p0_item(a.w_out, 1024, 1024, Wout_t + (size_t)(nb * 32) * 1024, kb * 64, nb * 32, 1, scr, lane); }
    }
    bf16* XN = (bf16*)(a.ws + WS_XN);
    f32x4 g[4];
#pragma unroll
    for (int j = 0; j < 4; ++j) g[j] = ((const f32x4*)a.g1)[64 * j + lane];
    for (int m = gw; m < NTOK; m += NGW) {
        const f32x4* xr = (const f32x4*)(a.x + (size_t)m * DM) + lane;
        f32x4 v[4]; float s = 0.f;
#pragma unroll
        for (int j = 0; j < 4; ++j) { v[j] = xr[64 * j]; s += (v[j].x * v[j].x + v[j].y * v[j].y) + (v[j].z * v[j].z + v[j].w * v[j].w); }
        const float rstd = 1.0f / sqrtf(wave_sum(s) * (1.0f / DM) + EPS);
        v2u* o8 = (v2u*)(XN + (size_t)m * DM) + lane;
#pragma unroll
        for (int j = 0; j < 4; ++j) { v2u w; w.x = pk2(v[j].x * rstd * g[j].x, v[j].y * rstd * g[j].y); w.y = pk2(v[j].z * rstd * g[j].z, v[j].w * rstd * g[j].w); o8[64 * j] = w; }
    }
    float* CS = (float*)(a.ws + WS_CS);
    for (int idx = gw * 64 + lane; idx < NTOK * 32; idx += NGW * 64) {
        const int tok = idx >> 5, i = idx & 31;
        const float inv = exp2f(-(float)i * 0.41524101186092029f);
        const float ang = (float)a.pos[tok] * inv;
        double r = (double)ang * 0.15915494309189535; r -= floor(r);
        const float rf = (float)r;
        CS[(size_t)tok * 64 + i] = __builtin_amdgcn_cosf(rf); CS[(size_t)tok * 64 + 32 + i] = __builtin_amdgcn_sinf(rf);
    }
}

__device__ __forceinline__ void p2_qkprep(const Args& a, int gtid, int NGT) {
    const bf16* PROJ = (const bf16*)(a.ws + WS_PROJ); const float* CS = (const float*)(a.ws + WS_CS);
    for (int it = gtid; it < NTOK * 16; it += NGT) {
        const int tok = it >> 4, hh = it & 15, isk = hh >> 3, h = hh & 7;
        const v4u* src = (const v4u*)(PROJ + (size_t)tok * INC + (isk ? C_AK : C_AQ) + h * 64);
        float xv[64];
#pragma unroll
        for (int c = 0; c < 8; ++c) { const v4u w = src[c]; xv[8 * c + 0] = bflo(w.x); xv[8 * c + 1] = bfhi(w.x); xv[8 * c + 2] = bflo(w.y); xv[8 * c + 3] = bfhi(w.y);
            xv[8 * c + 4] = bflo(w.z); xv[8 * c + 5] = bfhi(w.z); xv[8 * c + 6] = bflo(w.w); xv[8 * c + 7] = bfhi(w.w); }
        float ss = 0.f;
#pragma unroll
        for (int i = 0; i < 64; ++i) ss += xv[i] * xv[i];
        const float rstd = (1.0f / sqrtf(ss * (1.0f / 64.0f) + EPS)) * (isk ? 1.0f : 0.125f * 1.4426950408889634f);
        const float* gn = isk ? a.kg : a.qg;
        const float* cs = CS + (size_t)tok * 64;
        float ov[64];
#pragma unroll
        for (int i = 0; i < 32; ++i) { const float x1 = xv[i] * rstd * gn[i], x2 = xv[i + 32] * rstd * gn[i + 32], c = cs[i], s = cs[32 + i];
            ov[i] = x1 * c - x2 * s; ov[i + 32] = x2 * c + x1 * s; }
        v4u* dst = (v4u*)((bf16*)(a.ws + (isk ? WS_KR : WS_QR)) + (size_t)tok * 512 + h * 64);
#pragma unroll
        for (int c = 0; c < 8; ++c) { v4u w; w.x = pk2(ov[8 * c], ov[8 * c + 1]); w.y = pk2(ov[8 * c + 2], ov[8 * c + 3]); w.z = pk2(ov[8 * c + 4], ov[8 * c + 5]); w.w = pk2(ov[8 * c + 6], ov[8 * c + 7]); dst[c] = w; }
    }
}

__device__ __forceinline__ void p3_attn_naive(const Args& a, int gtid, int NGT) {
    const bf16* PROJ = (const bf16*)(a.ws + WS_PROJ); const bf16* QR = (const bf16*)(a.ws + WS_QR); const bf16* KR = (const bf16*)(a.ws + WS_KR);
    bf16* MIX = (bf16*)(a.ws + WS_MIX);
    for (int it = gtid; it < NTOK * 8; it += NGT) {
        const int tok = it >> 3, h = it & 7, b = tok / SEQ, t = tok % SEQ;
        float q[64], acc[64];
        { const v4u* src = (const v4u*)(QR + (size_t)tok * 512 + h * 64);
#pragma unroll
          for (int c = 0; c < 8; ++c) { const v4u w = src[c]; q[8 * c + 0] = bflo(w.x); q[8 * c + 1] = bfhi(w.x); q[8 * c + 2] = bflo(w.y); q[8 * c + 3] = bfhi(w.y);
              q[8 * c + 4] = bflo(w.z); q[8 * c + 5] = bfhi(w.z); q[8 * c + 6] = bflo(w.w); q[8 * c + 7] = bfhi(w.w); } }
#pragma unroll
        for (int i = 0; i < 64; ++i) acc[i] = 0.f;
        float m = -1e30f, l = 0.f;
        for (int p = 0; p < 3; ++p) { const int dil = 1 << (2 * p);
            for (int j = -64; j <= 64; ++j) { const int s = t + j * dil; if (s < 0 || s >= SEQ) continue;
                const size_t kt = (size_t)b * SEQ + s;
                const v4u* kp = (const v4u*)(KR + kt * 512 + h * 64); const v4u* vp = (const v4u*)(PROJ + kt * INC + C_AV + h * 64);
                float sc = 0.f;
#pragma unroll
                for (int c = 0; c < 8; ++c) { const v4u w = kp[c]; sc += q[8 * c] * bflo(w.x) + q[8 * c + 1] * bfhi(w.x) + q[8 * c + 2] * bflo(w.y) + q[8 * c + 3] * bfhi(w.y)
                    + q[8 * c + 4] * bflo(w.z) + q[8 * c + 5] * bfhi(w.z) + q[8 * c + 6] * bflo(w.w) + q[8 * c + 7] * bfhi(w.w); }
                const float mn = fmaxf(m, sc), corr = __expf(m - mn), pe = __expf(sc - mn);
                l = l * corr + pe; m = mn;
#pragma unroll
                for (int c = 0; c < 8; ++c) { const v4u w = vp[c];
                    acc[8 * c + 0] = acc[8 * c + 0] * corr + pe * bflo(w.x); acc[8 * c + 1] = acc[8 * c + 1] * corr + pe * bfhi(w.x);
                    acc[8 * c + 2] = acc[8 * c + 2] * corr + pe * bflo(w.y); acc[8 * c + 3] = acc[8 * c + 3] * corr + pe * bfhi(w.y);
                    acc[8 * c + 4] = acc[8 * c + 4] * corr + pe * bflo(w.z); acc[8 * c + 5] = acc[8 * c + 5] * corr + pe * bfhi(w.z);
                    acc[8 * c + 6] = acc[8 * c + 6] * corr + pe * bflo(w.w); acc[8 * c + 7] = acc[8 * c + 7] * corr + pe * bfhi(w.w); }
            } }
        const float il = 1.0f / l;
        v4u* dst = (v4u*)(MIX + (size_t)tok * 1024 + 512 + h * 64);
#pragma unroll
        for (int c = 0; c < 8; ++c) { v4u w; w.x = pk2(acc[8 * c] * il, acc[8 * c + 1] * il); w.y = pk2(acc[8 * c + 2] * il, acc[8 * c + 3] * il);
            w.z = pk2(acc[8 * c + 4] * il, acc[8 * c + 5] * il); w.w = pk2(acc[8 * c + 6] * il, acc[8 * c + 7] * il); dst[c] = w; }
    }
}

__device__ __forceinline__ void p3_hgrn_naive(const Args& a, LAS unsigned char* lds, int tid) {
    const bf16* PROJ = (const bf16*)(a.ws + WS_PROJ); float* OF = (float*)(a.ws + WS_OF);
    LAS float* FB = (LAS float*)(lds + L_HG);
    const int grp = tid >> 7, e = tid & 127, G = (int)blockIdx.x * 4 + grp, dir = G & 1, bh = G >> 1, b = bh >> 2, h = bh & 3;
    const float a0 = a.lb[dir * 512 + h * 128 + e], a1 = a.lb[1024 + dir * 512 + h * 128 + e];
    const float lbv = 1.0f / (1.0f + expf(a1 - a0));
    float S[128];
#pragma unroll
    for (int d = 0; d < 128; ++d) S[d] = 0.f;
    for (int step = 0; step < SEQ; ++step) {
        const int t = dir ? (SEQ - 1 - step) : step; const size_t tok = (size_t)b * SEQ + t;
        const bf16* pr = PROJ + tok * INC + h * 128 + e;
        const float z = bf2f(pr[dir ? C_HFB : C_HFF]), qraw = bf2f(pr[C_HQ]), vv = bf2f(pr[C_HI]);
        const float sg = sigm(z), f = lbv + (1.0f - lbv) * sg, k = (1.0f - lbv) * (1.0f - sg), qv = qraw * sigm(qraw);
        LAS float* fb = FB + ((step & 1) * 4 + grp) * 384;
        fb[e] = f; fb[128 + e] = k; fb[256 + e] = qv;
        __syncthreads();
        float o = 0.f;
#pragma unroll
        for (int d4 = 0; d4 < 32; ++d4) { const f32x4 F4 = *(const LAS f32x4*)(fb + 4 * d4), K4 = *(const LAS f32x4*)(fb + 128 + 4 * d4), Q4 = *(const LAS f32x4*)(fb + 256 + 4 * d4);
#pragma unroll
            for (int i = 0; i < 4; ++i) { S[4 * d4 + i] = F4[i] * S[4 * d4 + i] + K4[i] * vv; o += Q4[i] * S[4 * d4 + i]; } }
        OF[((size_t)dir * NTOK + tok) * 512 + h * 128 + e] = o;
    }
}

__device__ __forceinline__ void p4_hgrn_final(const Args& a, int gw, int NGW, int lane) {
    const bf16* PROJ = (const bf16*)(a.ws + WS_PROJ); const float* OF = (const float*)(a.ws + WS_OF); bf16* MIX = (bf16*)(a.ws + WS_MIX);
    const int c0 = 8 * lane;
    f32x4 gA = *(const f32x4*)(a.og + (c0 & 127)), gB = *(const f32x4*)(a.og + (c0 & 127) + 4);
    for (int tok = gw; tok < NTOK; tok += NGW) {
        const float* f0 = OF + (size_t)tok * 512 + c0; const float* f1 = OF + ((size_t)NTOK + tok) * 512 + c0;
        const f32x4 o0 = *(const f32x4*)f0 + *(const f32x4*)f1, o1 = *(const f32x4*)(f0 + 4) + *(const f32x4*)(f1 + 4);
        float ss = (o0.x * o0.x + o0.y * o0.y) + (o0.z * o0.z + o0.w * o0.w) + (o1.x * o1.x + o1.y * o1.y) + (o1.z * o1.z + o1.w * o1.w);
        ss += __shfl_xor(ss, 1); ss += __shfl_xor(ss, 2); ss += __shfl_xor(ss, 4); ss += __shfl_xor(ss, 8);
        const float rstd = 1.0f / sqrtf(ss * (1.0f / 128.0f) + EPS);
        const v4u hgw = *(const v4u*)(PROJ + (size_t)tok * INC + C_HG + c0);
        float hg[8] = {bflo(hgw.x), bfhi(hgw.x), bflo(hgw.y), bfhi(hgw.y), bflo(hgw.z), bfhi(hgw.z), bflo(hgw.w), bfhi(hgw.w)};
        float r[8] = {o0.x * gA.x, o0.y * gA.y, o0.z * gA.z, o0.w * gA.w, o1.x * gB.x, o1.y * gB.y, o1.z * gB.z, o1.w * gB.w};
#pragma unroll
        for (int i = 0; i < 8; ++i) r[i] = r[i] * rstd * hg[i] * sigm(hg[i]);
        v4u w; w.x = pk2(r[0], r[1]); w.y = pk2(r[2], r[3]); w.z = pk2(r[4], r[5]); w.w = pk2(r[6], r[7]);
        *(v4u*)(MIX + (size_t)tok * 1024 + c0) = w;
    }
}

__device__ __forceinline__ void p6_router(const Args& a, LAS unsigned char* lds, int tid, int lane, int wave) {
    LAS float* WrT = (LAS float*)lds;
    LAS int* lhist = (LAS int*)(lds + L_HIST);
    for (int idx = tid; idx < 32768; idx += NTHREADS) { const int k = idx >> 5, e = idx & 31; WrT[e * 1024 + k] = a.w_r[idx]; }
    if (tid < 32) lhist[tid] = 0;
    __syncthreads();
    bf16* XN = (bf16*)(a.ws + WS_XN);
    int* tope = (int*)(a.ws + WS_RT + RT_TOPE); float* topg = (float*)(a.ws + WS_RT + RT_TOPG); int* hist = (int*)(a.ws + WS_RT + RT_HIST);
    f32x4 g[4];
#pragma unroll
    for (int j = 0; j < 4; ++j) g[j] = ((const f32x4*)a.g2)[64 * j + lane];
    const float br = a.b_r[lane & 31];
    for (int blk = (int)blockIdx.x; blk < NTOK / 64; blk += (int)gridDim.x) {
        for (int rr = 0; rr < 8; ++rr) {
            const int row = blk * 64 + wave * 8 + rr;
            const f32x4* xr = (const f32x4*)(a.out + (size_t)row * DM) + lane;
            f32x4 v[4]; float s = 0.f;
#pragma unroll
            for (int j = 0; j < 4; ++j) { v[j] = xr[64 * j]; s += (v[j].x * v[j].x + v[j].y * v[j].y) + (v[j].z * v[j].z + v[j].w * v[j].w); }
            const float rstd = 1.0f / sqrtf(wave_sum(s) * (1.0f / DM) + EPS);
            v2u* o8 = (v2u*)(XN + (size_t)row * DM) + lane;
#pragma unroll
            for (int j = 0; j < 4; ++j) { v[j] = v[j] * rstd * g[j]; v2u w; w.x = pk2(v[j].x, v[j].y); w.y = pk2(v[j].z, v[j].w); o8[64 * j] = w; }
            float vals[32];
#pragma unroll
            for (int e = 0; e < 32; ++e) { float p = 0.f;
#pragma unroll
                for (int j = 0; j < 4; ++j) { const f32x4 w = *(const LAS f32x4*)(WrT + e * 1024 + 256 * j + 4 * lane); p += (v[j].x * w.x + v[j].y * w.y) + (v[j].z * w.z + v[j].w * w.w); }
                vals[e] = p; }
#pragma unroll
            for (int sft = 0; sft < 5; ++sft) { const int msk = 1 << sft; const bool up = (lane & msk) != 0;
#pragma unroll
                for (int i = 0; i < (16 >> sft); ++i) { const float lo = vals[2 * i], hi = vals[2 * i + 1]; const float send = up ? lo : hi, keep = up ? hi : lo; vals[i] = keep + __shfl_xor(send, msk); } }
            float logit = vals[0] + __shfl_xor(vals[0], 32) + br;
            int myi = lane & 31; float tv[4]; int ti[4]; float cur = logit;
#pragma unroll
            for (int k = 0; k < 4; ++k) { float bv = cur; int bi = myi;
#pragma unroll
                for (int o = 1; o < 32; o <<= 1) { const float ov = __shfl_xor(bv, o); const int oi = __shfl_xor(bi, o); if (ov > bv || (ov == bv && oi < bi)) { bv = ov; bi = oi; } }
                tv[k] = bv; ti[k] = bi; if (myi == bi) cur = -3.0e38f; }
            const float e1 = __expf(tv[1] - tv[0]), e2 = __expf(tv[2] - tv[0]), e3 = __expf(tv[3] - tv[0]); const float inv = 1.0f / (1.0f + e1 + e2 + e3);
            if (lane < 4) { const int ee = lane == 0 ? ti[0] : lane == 1 ? ti[1] : lane == 2 ? ti[2] : ti[3]; const float gg = (lane == 0 ? 1.0f : lane == 1 ? e1 : lane == 2 ? e2 : e3) * inv;
                tope[row * 4 + lane] = ee; topg[row * 4 + lane] = gg; __hip_atomic_fetch_add(&lhist[ee], 1, __ATOMIC_RELAXED, __HIP_MEMORY_SCOPE_WORKGROUP); }
        }
        __syncthreads();
        if (tid < 32) { hist[blk * 32 + tid] = lhist[tid]; lhist[tid] = 0; }
        __syncthreads();
    }
}

__device__ __forceinline__ void moe_tables(const Args& a, LAS unsigned char* lds, int tid, int blk) {
    const int* hist = (const int*)(a.ws + WS_RT + RT_HIST);
    LAS int* tot = (LAS int*)(lds + L_TOT); LAS int* mine = (LAS int*)(lds + L_MINE); LAS int* pads = (LAS int*)(lds + L_PADS); LAS unsigned char* texp = (LAS unsigned char*)(lds + L_TEXP);
    LAS int* part = (LAS int*)lds;
    { const int e = tid & 31, pt = tid >> 5; int t = 0, m = 0;
#pragma unroll
      for (int q = 0; q < 16; ++q) { const int b2 = pt * 16 + q; const int hv = hist[b2 * 32 + e]; t += hv; m += (b2 < blk) ? hv : 0; }
      part[pt * 32 + e] = t; part[512 + pt * 32 + e] = m; }
    __syncthreads();
    if (tid < 32) { int t = 0, m = 0;
#pragma unroll
      for (int q = 0; q < 16; ++q) { t += part[q * 32 + tid]; m += part[512 + q * 32 + tid]; }
      tot[tid] = t; mine[tid] = m; }
    __syncthreads();
    if (tid == 0) { int ps = 0, nt = 0;
#pragma unroll 1
        for (int e = 0; e < 32; ++e) { pads[e] = ps; const int tl = (tot[e] + 255) >> 8;
#pragma unroll 1
            for (int q = 0; q < tl; ++q) texp[nt + q] = (unsigned char)e;
            nt += tl; ps += tl * 256; } pads[32] = nt; }
    __syncthreads();
}

__device__ __forceinline__ void p7_gather(const Args& a, LAS unsigned char* lds, int tid, int lane, int wave) {
    const int* tope = (const int*)(a.ws + WS_RT + RT_TOPE); const float* topg = (const float*)(a.ws + WS_RT + RT_TOPG);
    int* slot = (int*)(a.ws + WS_RT + RT_SLOT); float* rgate = (float*)(a.ws + WS_RT + RT_GATE);
    const bf16* XN = (const bf16*)(a.ws + WS_XN); bf16* XS = (bf16*)(a.ws + WS_XS);
    LAS int* mine = (LAS int*)(lds + L_MINE); LAS int* pads = (LAS int*)(lds + L_PADS); LAS int* ite = (LAS int*)(lds + L_ITE); LAS int* itp = (LAS int*)(lds + L_ITP);
    for (int blk = (int)blockIdx.x; blk < NTOK / 64; blk += (int)gridDim.x) {
        moe_tables(a, lds, tid, blk);
        if (tid < 256) ite[tid] = tope[blk * 256 + tid];
        __syncthreads();
        if (tid < 32) { int rk = pads[tid] + mine[tid];
#pragma unroll 1
            for (int i = 0; i < 256; ++i) if (ite[i] == tid) itp[i] = rk++; }
        __syncthreads();
        if (tid < 256) { const int p = itp[tid]; slot[blk * 256 + tid] = p; rgate[p] = topg[blk * 256 + tid]; }
        for (int i = wave; i < 256; i += NWAVES) { const int p = itp[i]; const int row = blk * 64 + (i >> 2);
            const v4u* s = (const v4u*)(XN + (size_t)row * DM); v4u* d = (v4u*)(XS + (size_t)p * DM); d[lane] = s[lane]; d[lane + 64] = s[lane + 64]; }
        __syncthreads();
    }
}

__device__ __forceinline__ void p10_combine(const Args& a, int gw, int NGW, int lane) {
    const int* slot = (const int*)(a.ws + WS_RT + RT_SLOT); const bf16* Y = (const bf16*)(a.ws + WS_XS);
    for (int tok = gw; tok < NTOK; tok += NGW) {
        const int r0 = slot[tok * 4], r1 = slot[tok * 4 + 1], r2 = slot[tok * 4 + 2], r3 = slot[tok * 4 + 3];
        f32x4* o = (f32x4*)(a.out + (size_t)tok * DM) + lane;
#pragma unroll
        for (int j = 0; j < 4; ++j) { f32x4 v = o[64 * j];
            const v2u y0 = ((const v2u*)(Y + (size_t)r0 * DM))[64 * j + lane], y1 = ((const v2u*)(Y + (size_t)r1 * DM))[64 * j + lane], y2 = ((const v2u*)(Y + (size_t)r2 * DM))[64 * j + lane], y3 = ((const v2u*)(Y + (size_t)r3 * DM))[64 * j + lane];
            v.x += (bflo(y0.x) + bflo(y1.x)) + (bflo(y2.x) + bflo(y3.x)); v.y += (bfhi(y0.x) + bfhi(y1.x)) + (bfhi(y2.x) + bfhi(y3.x));
            v.z += (bflo(y0.y) + bflo(y1.y)) + (bflo(y2.y) + bflo(y3.y)); v.w += (bfhi(y0.y) + bfhi(y1.y)) + (bfhi(y2.y) + bfhi(y3.y));
            o[64 * j] = v; }
    }
}


typedef float f32x16 __attribute__((ext_vector_type(16)));
typedef short bf16x8 __attribute__((ext_vector_type(8)));
typedef short s16x4 __attribute__((ext_vector_type(4)));
typedef float f32x2_t __attribute__((ext_vector_type(2)));
typedef __bf16 bf16x2_t __attribute__((ext_vector_type(2)));
__device__ __forceinline__ int crow(int r, int hi) { return (r & 3) + 8 * (r >> 2) + 4 * hi; }
__device__ __forceinline__ unsigned cvtpk(float lo, float hi) { f32x2_t v = {lo, hi}; bf16x2_t b = __builtin_convertvector(v, bf16x2_t); return __builtin_bit_cast(unsigned, b); }
__device__ __forceinline__ s16x4 vtr(const LAS unsigned char* p) { return __builtin_bit_cast(s16x4, __builtin_amdgcn_ds_read_tr16_b64_v4i16((LAS s16x4*)p)); }
#define VFRAG(lo, hi) (bf16x8){lo[0], lo[1], lo[2], lo[3], hi[0], hi[1], hi[2], hi[3]}
__device__ __forceinline__ bf16x8 pfrag(const f32x16& s, int b) { v4u w; w.x = cvtpk(s[b], s[b + 1]); w.y = cvtpk(s[b + 2], s[b + 3]); w.z = cvtpk(s[b + 4], s[b + 5]); w.w = cvtpk(s[b + 6], s[b + 7]); return __builtin_bit_cast(bf16x8, w); }

constexpr size_t WS_US = 432 * MiB;
constexpr size_t WS_OP = 786 * MiB;
constexpr size_t WS_AD = 834 * MiB;
constexpr size_t WS_LP = 835 * MiB;
constexpr size_t WS_END2 = 838 * MiB;

__device__ __forceinline__ void attn_unit(const Args& a, LAS unsigned char* wl, int wu, int lane, float Bl2) {
    const bf16* PROJ = (const bf16*)(a.ws + WS_PROJ); const bf16* QR = (const bf16*)(a.ws + WS_QR); const bf16* KR = (const bf16*)(a.ws + WS_KR);
    const int tile = wu & 255, r_ = wu >> 8, p = r_ % 3, bh = r_ / 3, b = bh >> 3, h = bh & 7;
    const int dsh = 2 * p, dil = 1 << dsh, tpr = 256 >> dsh, r = tile >> (8 - dsh), l0 = (tile & (tpr - 1)) * 32, L = SEQ >> dsh;
    const int r32 = lane & 31, hi = lane >> 5;
    const size_t tb = (size_t)b * SEQ + r;
    bf16x8 qf[4];
    { const bf16* qp = QR + (tb + (size_t)(l0 + r32) * dil) * 512 + h * 64 + hi * 8;
#pragma unroll
      for (int d0 = 0; d0 < 4; ++d0) qf[d0] = *(const bf16x8*)(qp + d0 * 16); }
    f32x16 o0, o1;
#pragma unroll
    for (int i = 0; i < 16; ++i) { o0[i] = 0.f; o1[i] = 0.f; }
    float lsum = 0.f;
    const LAS unsigned char* vb = wl + (4 * hi + ((lane & 15) >> 2)) * 64 + ((lane >> 4) & 1) * 32 + (lane & 3) * 8;
    for (int kt = 0; kt < 5; ++kt) {
        const int kb = l0 - 64 + 32 * kt;
        if (kb + 31 < 0 || kb >= L) continue;
        int lk = kb + r32; lk = lk < 0 ? 0 : (lk >= L ? L - 1 : lk);
        const bf16* kp = KR + (tb + (size_t)lk * dil) * 512 + h * 64 + hi * 8;
        bf16x8 kf[4];
#pragma unroll
        for (int d0 = 0; d0 < 4; ++d0) kf[d0] = *(const bf16x8*)(kp + d0 * 16);
        v4u vv[4];
#pragma unroll
        for (int i = 0; i < 4; ++i) { int lv = kb + 8 * i + (lane >> 3); lv = lv < 0 ? 0 : (lv >= L ? L - 1 : lv);
            vv[i] = *(const v4u*)(PROJ + (tb + (size_t)lv * dil) * INC + C_AV + h * 64 + (lane & 7) * 8); }
#pragma unroll
        for (int i = 0; i < 4; ++i) { const int kr = 8 * i + (lane >> 3), c = lane & 7; *(LAS v4u*)(wl + (c >> 2) * 2048 + (kr >> 3) * 512 + (kr & 7) * 64 + (c & 3) * 16) = vv[i]; }
        f32x16 s;
#pragma unroll
        for (int i = 0; i < 16; ++i) s[i] = 0.f;
#pragma unroll
        for (int d0 = 0; d0 < 4; ++d0) s = __builtin_amdgcn_mfma_f32_32x32x16_bf16(kf[d0], qf[d0], s, 0, 0, 0);
#pragma unroll
        for (int rg = 0; rg < 16; ++rg) { const int key = kb + crow(rg, hi), dq = key - (l0 + r32);
            const bool ok = (dq >= -64) && (dq <= 64) && (key >= 0) && (key < L);
            const float pe = ok ? __builtin_amdgcn_exp2f(s[rg] - Bl2) : 0.f; lsum += pe; s[rg] = pe; }
        const bf16x8 pw0 = pfrag(s, 0), pw1 = pfrag(s, 8);
        { const s16x4 a0 = vtr(vb), a1 = vtr(vb + 512), b0 = vtr(vb + 1024), b1 = vtr(vb + 1536);
          o0 = __builtin_amdgcn_mfma_f32_32x32x16_bf16(pw0, VFRAG(a0, a1), o0, 0, 0, 0); o0 = __builtin_amdgcn_mfma_f32_32x32x16_bf16(pw1, VFRAG(b0, b1), o0, 0, 0, 0); }
        { const s16x4 a0 = vtr(vb + 2048), a1 = vtr(vb + 2048 + 512), b0 = vtr(vb + 2048 + 1024), b1 = vtr(vb + 2048 + 1536);
          o1 = __builtin_amdgcn_mfma_f32_32x32x16_bf16(pw0, VFRAG(a0, a1), o1, 0, 0, 0); o1 = __builtin_amdgcn_mfma_f32_32x32x16_bf16(pw1, VFRAG(b0, b1), o1, 0, 0, 0); }
    }
    lsum += __shfl_xor(lsum, 32);
    float* LP = (float*)(a.ws + WS_LP) + (size_t)p * NTOK * 8;
    if (hi == 0) LP[(tb + (size_t)(l0 + r32) * dil) * 8 + h] = lsum;
    LAS bf16* stg = (LAS bf16*)wl;
#pragma unroll
    for (int rg = 0; rg < 16; ++rg) { const int orow = crow(rg, hi); stg[orow * 64 + r32] = (bf16)f2bf(o0[rg]); stg[orow * 64 + 32 + r32] = (bf16)f2bf(o1[rg]); }
    bf16* OP = (bf16*)(a.ws + WS_OP) + (size_t)p * NTOK * 512;
#pragma unroll
    for (int i = 0; i < 4; ++i) { const int row = 8 * i + (lane >> 3), ch = lane & 7; const v4u v = *(const LAS v4u*)(wl + row * 128 + ch * 16);
        *(v4u*)(OP + (tb + (size_t)(l0 + row) * dil) * 512 + h * 64 + ch * 8) = v; }
}
__device__ __forceinline__ float attn_bound_l2(const Args& a, int lane) {
    float mq = fabsf(a.qg[lane]), mk = fabsf(a.kg[lane]);
#pragma unroll
    for (int o = 1; o < 64; o <<= 1) { mq = fmaxf(mq, __shfl_xor(mq, o)); mk = fmaxf(mk, __shfl_xor(mk, o)); }
    return 8.0f * mq * mk * 1.4426950408889634f + 0.5f;
}
__device__ __forceinline__ void p3_attn(const Args& a, LAS unsigned char* lds, int lane, int wave) {
    const float Bl2 = attn_bound_l2(a, lane);
    LAS unsigned char* wl = lds + 65536 + wave * 4096;
    for (int bu = (int)blockIdx.x; bu < BATCH * 8 * 3 * 256 / 8; bu += (int)gridDim.x) attn_unit(a, wl, bu * 8 + wave, lane, Bl2);
}

__device__ __forceinline__ int vt_off(int row, int col) { return (col >> 5) * 4096 + (row >> 3) * 512 + (row & 7) * 64 + (col & 31) * 2; }
__device__ __forceinline__ int sw_off(int row, int col) { return row * 256 + ((((col >> 3) ^ (row & 15)) << 4) | ((col & 7) * 2)); }
constexpr int H_V = 0, H_TOT = 16384, H_A = 18432;
#define HG_PASS1() \
    const int dir = tid >> 8, half = (tid >> 7) & 1, d = tid & 127; \
    const float la0 = a.lb[dir * 512 + h * 128 + d], la1 = a.lb[1024 + dir * 512 + h * 128 + d]; \
    const float lbv = 1.0f / (1.0f + __expf(la1 - la0)), oml = 1.0f - lbv; \
    float g[32], kk[32]; \
    { const bf16* zp = PROJ + (t0 + (size_t)half * 32) * INC + (dir ? C_HFB : C_HFF) + h * 128 + d; float tsum = 0.f; \
      _Pragma("unroll") for (int i = 0; i < 32; ++i) { const float z = bf2f(zp[(size_t)i * INC]); const float sg = sigm(z); const float f = lbv + oml * sg; g[i] = __logf(f); kk[i] = oml * (1.0f - sg); tsum += g[i]; } \
      tot[(dir * 2 + half) * 128 + d] = tsum; } \
    __syncthreads(); \
    const float tother = tot[(dir * 2 + (half ^ 1)) * 128 + d];

__device__ __forceinline__ void hg_load_v(const bf16* PROJ, size_t t0, int h, LAS unsigned char* lds, int tid) {
#pragma unroll
    for (int i = 0; i < 2; ++i) { const int idx = tid + 512 * i, row = idx >> 4, ch = idx & 15;
        const v4u w = *(const v4u*)(PROJ + (t0 + row) * INC + C_HI + h * 128 + ch * 8); *(LAS v4u*)(lds + H_V + vt_off(row, ch * 8)) = w; }
}
__device__ __forceinline__ void hg_summary_item(const Args& a, LAS unsigned char* lds, int item, int tid, int lane, int wave) {
    const bf16* PROJ = (const bf16*)(a.ws + WS_PROJ);
    const int bh = item >> 7, n = item & 127, b = bh >> 2, h = bh & 3; const size_t t0 = (size_t)b * SEQ + 64 * n;
    LAS float* tot = (LAS float*)(lds + H_TOT); LAS unsigned char* kut = lds + H_A;
    hg_load_v(PROJ, t0, h, lds, tid);
    HG_PASS1();
    { unsigned pk[16];
      if (dir == 0) { float run = half ? 0.f : tother;
#pragma unroll
          for (int i = 31; i >= 0; --i) { const float v = kk[i] * __expf(run); run += g[i]; if (i & 1) pk[i >> 1] = f2bf(v) << 16; else pk[i >> 1] |= f2bf(v); } }
      else { float run = half ? tother : 0.f;
#pragma unroll
          for (int i = 0; i < 32; ++i) { const float v = kk[i] * __expf(run); run += g[i]; if (i & 1) pk[i >> 1] |= f2bf(v) << 16; else pk[i >> 1] = f2bf(v); } }
      LAS unsigned char* rowp = kut + (dir * 128 + d) * 144 + half * 64;
#pragma unroll
      for (int j = 0; j < 4; ++j) { v4u w; w.x = pk[4 * j]; w.y = pk[4 * j + 1]; w.z = pk[4 * j + 2]; w.w = pk[4 * j + 3]; *(LAS v4u*)(rowp + 16 * j) = w; }
      if (half == 0) ((float*)(a.ws + WS_AD))[(((size_t)dir * 8 + (b * 4 + h)) * 128 + n) * 128 + d] = __expf(tother + tot[(dir * 2) * 128 + d]);
    }
    __syncthreads();
    { const int wdir = wave >> 2, rt = wave & 3, r32 = lane & 31, hi = lane >> 5;
      bf16x8 af[4];
#pragma unroll
      for (int ks = 0; ks < 4; ++ks) af[ks] = *(const LAS bf16x8*)(kut + (wdir * 128 + 32 * rt + r32) * 144 + (16 * ks + 8 * hi) * 2);
      bf16* UT = (bf16*)(a.ws + WS_US) + ((((size_t)wdir * 8 + (b * 4 + h)) * 128 + n) << 14);
      const int q = (lane & 15) >> 2, pp = lane & 3, g1 = (lane >> 4) & 1;
#pragma unroll
      for (int ct = 0; ct < 4; ++ct) { f32x16 acc;
#pragma unroll
          for (int i = 0; i < 16; ++i) acc[i] = 0.f;
#pragma unroll
          for (int ks = 0; ks < 4; ++ks) { const int row = 16 * ks + 8 * hi + q, col = 32 * ct + 16 * g1 + 4 * pp;
              const s16x4 lo = vtr(lds + H_V + vt_off(row, col)), hh = vtr(lds + H_V + vt_off(row + 4, col));
              acc = __builtin_amdgcn_mfma_f32_32x32x16_bf16(af[ks], VFRAG(lo, hh), acc, 0, 0, 0); }
          bf16* up = UT + (size_t)(32 * ct + r32) * 128 + 32 * rt + 4 * hi;
#pragma unroll
          for (int q4 = 0; q4 < 4; ++q4) { v2u w; w.x = cvtpk(acc[4 * q4], acc[4 * q4 + 1]); w.y = cvtpk(acc[4 * q4 + 2], acc[4 * q4 + 3]); *(v2u*)(up + 8 * q4) = w; } }
    }
    __syncthreads();
}
__device__ __forceinline__ void hg_scan(const Args& a, int gtid, int NGT) {
    for (int idx = gtid; idx < 16 * 8192; idx += NGT) {
        const int chain = idx >> 13, e2 = idx & 8191, dk = (2 * e2) & 127, dir = chain >> 3;
        unsigned* U = (unsigned*)(a.ws + WS_US) + ((size_t)chain * 128 << 13) + e2;
        const float* AD = (const float*)(a.ws + WS_AD) + (size_t)chain * 128 * 128 + dk;
        float r0 = 0.f, r1 = 0.f;
#pragma unroll 8
        for (int st = 0; st < 128; ++st) { const int n = dir ? 127 - st : st;
            const unsigned u = U[(size_t)n << 13]; const f32x2_t av = *(const f32x2_t*)(AD + n * 128);
            U[(size_t)n << 13] = pk2(r0, r1);
            r0 = av.x * r0 + bflo(u); r1 = av.y * r1 + bfhi(u); }
    }
}
__device__ __forceinline__ void hg_output_item(const Args& a, LAS unsigned char* lds, int item, int tid, int lane, int wave) {
    const bf16* PROJ = (const bf16*)(a.ws + WS_PROJ);
    const int bh = item >> 7, n = item & 127, b = bh >> 2, h = bh & 3; const size_t t0 = (size_t)b * SEQ + 64 * n;
    LAS float* tot = (LAS float*)(lds + H_TOT); LAS unsigned char* QT = lds + H_A; LAS unsigned char* KT = lds + H_A + 32768;
    hg_load_v(PROJ, t0, h, lds, tid);
    HG_PASS1();
    { const bf16* qp = PROJ + (t0 + (size_t)half * 32) * INC + C_HQ + h * 128 + d;
      LAS unsigned char* qt = QT + dir * 16384; LAS unsigned char* kt = KT + dir * 16384;
      if (dir == 0) { float run = half ? tother : 0.f;
#pragma unroll
          for (int i = 0; i < 32; ++i) { run += g[i]; const float qr = bf2f(qp[(size_t)i * INC]); const float qv = qr * sigm(qr); const int c = half * 32 + i;
              *(LAS bf16*)(qt + sw_off(c, d)) = (bf16)f2bf(qv * __expf(run)); *(LAS bf16*)(kt + sw_off(c, d)) = (bf16)f2bf(kk[i] * __expf(-run)); } }
      else { float run = half ? 0.f : tother;
#pragma unroll
          for (int i = 31; i >= 0; --i) { run += g[i]; const float qr = bf2f(qp[(size_t)i * INC]); const float qv = qr * sigm(qr); const int c = half * 32 + i;
              *(LAS bf16*)(qt + sw_off(c, d)) = (bf16)f2bf(qv * __expf(run)); *(LAS bf16*)(kt + sw_off(c, d)) = (bf16)f2bf(kk[i] * __expf(-run)); } }
    }
    __syncthreads();
    const int ct = wave & 1, dvt = wave >> 1, r32 = lane & 31, hi = lane >> 5;
    f32x16 o;
#pragma unroll
    for (int i = 0; i < 16; ++i) o[i] = 0.f;
    { const int q = (lane & 15) >> 2, pp = lane & 3, g1 = (lane >> 4) & 1;
#pragma unroll
      for (int dr = 0; dr < 2; ++dr) {
          const LAS unsigned char* qt = QT + dr * 16384; const LAS unsigned char* kt = KT + dr * 16384;
          bf16x8 qf[8];
#pragma unroll
          for (int kd = 0; kd < 8; ++kd) qf[kd] = *(const LAS bf16x8*)(qt + sw_off(32 * ct + r32, 16 * kd + 8 * hi));
#pragma unroll
          for (int st = 0; st < 2; ++st) {
              if (dr == 0 ? (st > ct) : (st < ct)) continue;
              f32x16 x;
#pragma unroll
              for (int i = 0; i < 16; ++i) x[i] = 0.f;
#pragma unroll
              for (int kd = 0; kd < 8; ++kd) { const bf16x8 kf = *(const LAS bf16x8*)(kt + sw_off(32 * st + r32, 16 * kd + 8 * hi)); x = __builtin_amdgcn_mfma_f32_32x32x16_bf16(kf, qf[kd], x, 0, 0, 0); }
              if (st == ct) {
#pragma unroll
                  for (int rg = 0; rg < 16; ++rg) { const int s_ = crow(rg, hi); const bool keep = dr == 0 ? (s_ <= r32) : (s_ >= r32); x[rg] = keep ? x[rg] : 0.f; } }
              const bf16x8 pw0 = pfrag(x, 0), pw1 = pfrag(x, 8);
              const int col = 32 * dvt + 16 * g1 + 4 * pp;
              { const int row = 32 * st + 4 * hi + q; const s16x4 lo = vtr(lds + H_V + vt_off(row, col)), hh = vtr(lds + H_V + vt_off(row + 8, col));
                o = __builtin_amdgcn_mfma_f32_32x32x16_bf16(pw0, VFRAG(lo, hh), o, 0, 0, 0); }
              { const int row = 32 * st + 16 + 4 * hi + q; const s16x4 lo = vtr(lds + H_V + vt_off(row, col)), hh = vtr(lds + H_V + vt_off(row + 8, col));
                o = __builtin_amdgcn_mfma_f32_32x32x16_bf16(pw1, VFRAG(lo, hh), o, 0, 0, 0); }
          }
          const bf16* ST = (const bf16*)(a.ws + WS_US) + ((((size_t)dr * 8 + (b * 4 + h)) * 128 + n) << 14) + (size_t)(32 * dvt + r32) * 128 + 8 * hi;
#pragma unroll
          for (int kd = 0; kd < 8; ++kd) { const bf16x8 sf = *(const bf16x8*)(ST + 16 * kd); o = __builtin_amdgcn_mfma_f32_32x32x16_bf16(qf[kd], sf, o, 0, 0, 0); }
      } }
    __syncthreads();
    LAS float* stg = (LAS float*)(lds + H_A);
#pragma unroll
    for (int rg = 0; rg < 16; ++rg) stg[(32 * ct + crow(rg, hi)) * 132 + 32 * dvt + r32] = o[rg];
    __syncthreads();
    { const int row = tid >> 3, seg = tid & 7; const LAS float* sp = stg + row * 132 + 16 * seg; float v[16]; float ss = 0.f;
#pragma unroll
      for (int j = 0; j < 4; ++j) { const f32x4 w = *(const LAS f32x4*)(sp + 4 * j); v[4 * j] = w.x; v[4 * j + 1] = w.y; v[4 * j + 2] = w.z; v[4 * j + 3] = w.w; ss += (w.x * w.x + w.y * w.y) + (w.z * w.z + w.w * w.w); }
      ss += __shfl_xor(ss, 1); ss += __shfl_xor(ss, 2); ss += __shfl_xor(ss, 4);
      const float rstd = 1.0f / sqrtf(ss * (1.0f / 128.0f) + EPS);
      const v4u h0 = *(const v4u*)(PROJ + (t0 + row) * INC + C_HG + h * 128 + 16 * seg), h1 = *(const v4u*)(PROJ + (t0 + row) * INC + C_HG + h * 128 + 16 * seg + 8);
      const float hg[16] = {bflo(h0.x), bfhi(h0.x), bflo(h0.y), bfhi(h0.y), bflo(h0.z), bfhi(h0.z), bflo(h0.w), bfhi(h0.w), bflo(h1.x), bfhi(h1.x), bflo(h1.y), bfhi(h1.y), bflo(h1.z), bfhi(h1.z), bflo(h1.w), bfhi(h1.w)};
      float r[16];
#pragma unroll
      for (int j = 0; j < 16; ++j) r[j] = v[j] * rstd * a.og[16 * seg + j] * hg[j] * sigm(hg[j]);
      v4u w0, w1; w0.x = pk2(r[0], r[1]); w0.y = pk2(r[2], r[3]); w0.z = pk2(r[4], r[5]); w0.w = pk2(r[6], r[7]); w1.x = pk2(r[8], r[9]); w1.y = pk2(r[10], r[11]); w1.z = pk2(r[12], r[13]); w1.w = pk2(r[14], r[15]);
      bf16* mp = (bf16*)(a.ws + WS_MIX) + (t0 + row) * 1024 + h * 128 + 16 * seg; *(v4u*)mp = w0; *(v4u*)(mp + 8) = w1; }
    __syncthreads();
}
__device__ __forceinline__ void attn_merge(const Args& a, int gw, int NGW, int lane) {
    const bf16* OP = (const bf16*)(a.ws + WS_OP); const float* LP = (const float*)(a.ws + WS_LP); bf16* MIX = (bf16*)(a.ws + WS_MIX);
    for (int tok = gw; tok < NTOK; tok += NGW) {
        float acc[8] = {0.f, 0.f, 0.f, 0.f, 0.f, 0.f, 0.f, 0.f}; float l = 0.f;
#pragma unroll
        for (int p = 0; p < 3; ++p) { const v4u w = *(const v4u*)(OP + ((size_t)p * NTOK + tok) * 512 + lane * 8); l += LP[((size_t)p * NTOK + tok) * 8 + (lane >> 3)];
            acc[0] += bflo(w.x); acc[1] += bfhi(w.x); acc[2] += bflo(w.y); acc[3] += bfhi(w.y); acc[4] += bflo(w.z); acc[5] += bfhi(w.z); acc[6] += bflo(w.w); acc[7] += bfhi(w.w); }
        const float il = 1.0f / l; v4u w; w.x = pk2(acc[0] * il, acc[1] * il); w.y = pk2(acc[2] * il, acc[3] * il); w.z = pk2(acc[4] * il, acc[5] * il); w.w = pk2(acc[6] * il, acc[7] * il);
        *(v4u*)(MIX + (size_t)tok * 1024 + 512 + lane * 8) = w;
    }
}

__global__ void __launch_bounds__(NTHREADS, 2) mk_fwd(Args a) {
    extern __shared__ __attribute__((aligned(16))) unsigned char lds_raw[];
    LAS unsigned char* lds = (LAS unsigned char*)lds_raw;
    const int tid = threadIdx.x, lane = tid & 63, wave = __builtin_amdgcn_readfirstlane(tid >> 6);
    const int G = gridDim.x, bx = blockIdx.x;
    const int vcu = (G % 8 == 0) ? (bx % 8) * (G / 8) + bx / 8 : bx;
    const int gw = vcu * NWAVES + wave, NGW = G * NWAVES, gtid = bx * NTHREADS + tid, NGT = G * NTHREADS;
    unsigned* ctl = (unsigned*)(a.ws + WS_CTL);
    for (int u = tid; u < (LDS_BYTES - LDSCTL_OFF) / 4; u += NTHREADS) ((LAS unsigned*)(lds + LDSCTL_OFF))[u] = 0u;
    __syncthreads();
    XcdBarrier bar; bar.bar = ctl + CW_BAR; bar.x = 0; bar.st = nullptr;
    if (!MK_PER_PHASE) bar = xcd_barrier_post(ctl + CW_BAR, (volatile LAS unsigned*)(lds + MISC_OFF) + 8);
    const int lo = a.ph_lo, hi = a.ph_hi;
#ifndef PH_MASK
#define PH_MASK 0xfff
#endif
#define IN(k) (((PH_MASK >> (k)) & 1) && lo <= (k) && (k) < hi)
#define SEAM(k) do { if (IN(k) && IN((k) + 1)) xcd_barrier(bar); } while (0)

    if (IN(0)) { p0_prologue(a, lds, gw, NGW, lane, wave); } SEAM(0);
    if (IN(1)) {
        pg8::Gemm g{(const pg8::bf16_t*)(a.ws + WS_XN), (const pg8::bf16_t*)(a.ws + WS_WIN), NTOK, INC, DM}; pg8::StaticOrder S; S.init(NTOK, INC, G, bx);
        pg8::EpiBf16<0> E{(pg8::bf16_t*)(a.ws + WS_PROJ), INC, nullptr, 0, 0, 1.f};
        pg8::gemm_phase<pg8::EpiBf16<0>, pg8::StaticOrder, true, true>(lds, g, S, E);
    } SEAM(1);
    if (IN(2)) { p2_qkprep(a, gtid, NGT); } SEAM(2);
    if (IN(3)) { p3_attn(a, lds, lane, wave);
#if HGRN_CHUNK
        for (int it = bx; it < 1024; it += G) hg_summary_item(a, lds, it, tid, lane, wave);
#endif
    } SEAM(3);
    if (IN(4)) {
#if HGRN_CHUNK
        hg_scan(a, gtid, NGT);
#endif
    } SEAM(4);
    if (IN(5)) {
#if HGRN_CHUNK
        for (int it = bx; it < 1024; it += G) hg_output_item(a, lds, it, tid, lane, wave);
#else
        p4_hgrn_final(a, gw, NGW, lane);
#endif
        attn_merge(a, gw, NGW, lane);
    } SEAM(5);
    if (IN(6)) {
        pg8::Gemm g{(const pg8::bf16_t*)(a.ws + WS_MIX), (const pg8::bf16_t*)(a.ws + WS_WOUT), NTOK, DM, DM}; pg8::StaticOrder S; S.init(NTOK, DM, G, bx);
        pg8::EpiResF32 E{a.x, a.out, DM};
        pg8::gemm_phase<pg8::EpiResF32, pg8::StaticOrder, true, true>(lds, g, S, E);
    } SEAM(6);
    if (IN(7)) { p6_router(a, lds, tid, lane, wave); } SEAM(7);
    if (IN(8)) { p7_gather(a, lds, tid, lane, wave); } SEAM(8);
    if (IN(9)) {
        if (lo == 9) moe_tables(a, lds, tid, 0);
        const int ntiles = ((LAS int*)(lds + L_PADS))[32];
        pg8::Gemm g{(const pg8::bf16_t*)(a.ws + WS_XS), (const pg8::bf16_t*)(a.ws + WS_WUP), PMAX, 2048, DM};
        pg8::MoeOrder S{8, ntiles * 8, G, bx, (const LAS unsigned char*)(lds + L_TEXP)};
        pg8::EpiSwiglu E{(pg8::bf16_t*)(a.ws + WS_ACT), a.b_up};
        pg8::gemm_phase<pg8::EpiSwiglu, pg8::MoeOrder, true, true>(lds, g, S, E);
    } SEAM(9);
    if (IN(10)) {
        if (lo == 10) moe_tables(a, lds, tid, 0);
        const int ntiles = ((LAS int*)(lds + L_PADS))[32];
        pg8::Gemm g{(const pg8::bf16_t*)(a.ws + WS_ACT), (const pg8::bf16_t*)(a.ws + WS_WDN), PMAX, 1024, DM};
        pg8::MoeOrder S{4, ntiles * 4, G, bx, (const LAS unsigned char*)(lds + L_TEXP)};
        pg8::EpiDown E{(pg8::bf16_t*)(a.ws + WS_XS), a.b_dn, (const float*)(a.ws + WS_RT + RT_GATE)};
        pg8::gemm_phase<pg8::EpiDown, pg8::MoeOrder, true, true>(lds, g, S, E);
    } SEAM(10);
    if (IN(11)) { p10_combine(a, gw, NGW, lane); }
#undef IN
#undef SEAM
}

__global__ void __launch_bounds__(NTHREADS, 2) mk_naive3(Args a) {
    extern __shared__ __attribute__((aligned(16))) unsigned char lds_raw[];
    LAS unsigned char* lds = (LAS unsigned char*)lds_raw;
    const int tid = threadIdx.x, bx = blockIdx.x, gtid = bx * NTHREADS + tid, NGT = gridDim.x * NTHREADS;
    if (bx < 4) p3_hgrn_naive(a, lds, tid);
}
extern "C" void kernel_launch(void* const* d_in, const int* in_sizes, int n_in, void* d_out, int out_size, void* d_ws, size_t ws_size, hipStream_t stream) {
    static int grid = 0;
    if (grid == 0) {
        if (n_in != 16 || in_sizes[0] != NTOK * DM || out_size != NTOK * DM || ws_size < WS_END2) { fprintf(stderr, "kernel_launch: unexpected shapes / workspace (%d inputs, ws %zu)\n", n_in, ws_size); grid = -1; return; }
        int dev = 0, cus = 0;
        if (hipGetDevice(&dev) != hipSuccess || hipDeviceGetAttribute(&cus, hipDeviceAttributeMultiprocessorCount, dev) != hipSuccess) { grid = -1; return; }
        if (hipFuncSetAttribute((const void*)mk_fwd, hipFuncAttributeMaxDynamicSharedMemorySize, LDS_BYTES) != hipSuccess || hipFuncSetAttribute((const void*)mk_naive3, hipFuncAttributeMaxDynamicSharedMemorySize, LDS_BYTES) != hipSuccess) { fprintf(stderr, "kernel_launch: hipFuncSetAttribute failed\n"); grid = -1; return; }
        (void)hipGetLastError();
        grid = cus;
    }
    if (grid < 0) return;
    if (hipMemsetAsync((char*)d_ws + WS_CTL, 0, CTL_ZERO_BYTES, stream) != hipSuccess) return;
    Args a{};
    a.x = (const float*)d_in[0]; a.pos = (const int*)d_in[1]; a.g1 = (const float*)d_in[2]; a.w_in = (const float*)d_in[3]; a.qg = (const float*)d_in[4]; a.kg = (const float*)d_in[5];
    a.lb = (const float*)d_in[6]; a.og = (const float*)d_in[7]; a.w_out = (const float*)d_in[8]; a.g2 = (const float*)d_in[9]; a.w_r = (const float*)d_in[10]; a.b_r = (const float*)d_in[11];
    a.w_up = (const float*)d_in[12]; a.b_up = (const float*)d_in[13]; a.w_dn = (const float*)d_in[14]; a.b_dn = (const float*)d_in[15];
    a.out = (float*)d_out; a.ws = (unsigned char*)d_ws;
#if MK_PER_PHASE
    for (int p = 0; p < NPHASE; ++p) { a.ph_lo = p; a.ph_hi = p + 1;
        hipLaunchKernelGGL(mk_fwd, dim3(grid), dim3(NTHREADS), LDS_BYTES, stream, a);
#if !HGRN_CHUNK
        if (p == 3) hipLaunchKernelGGL(mk_naive3, dim3(4), dim3(NTHREADS), LDS_BYTES, stream, a);
#endif
    }
#else
    a.ph_lo = 0; a.ph_hi = NPHASE; hipLaunchKernelGGL(mk_fwd, dim3(grid), dim3(NTHREADS), LDS_BYTES, stream, a);
#endif
}
```

```cpp
#include <hip/hip_runtime.h>
#include <cstdio>
#include <cstdint>
namespace pg8 {
#define PG8_LAS __attribute__((address_space(3)))
typedef unsigned short bf16_t;
typedef short bf16x8 __attribute__((ext_vector_type(8)));
typedef float f32x4 __attribute__((ext_vector_type(4)));
typedef unsigned u32x4 __attribute__((ext_vector_type(4)));
constexpr int BM = 256, BK = 64, HALF = 128, HTB = HALF * BK * 2  , STAGE_BYTES = 8 * HTB, NXCD = 8, WGM = 8;

__host__ __device__ __forceinline__ int lds_byte(int r, int c) { const int st = (r >> 4) * 2 + (c >> 5), rr = r & 15, cc = c & 31, ob = rr * 64 + cc * 2; return st * 1024 + (ob ^ (((ob >> 9) & 1) << 5)); }
__host__ __device__ __forceinline__ void stage_rc(int b, int& R, int& C) { const int st = b / 1024, sb = b % 1024, swz = sb ^ (((sb >> 9) & 1) << 5); R = (st >> 1) * 16 + swz / 64; C = (st & 1) * 32 + (swz % 64) / 2; }
__host__ __device__ __forceinline__ int perm32(int rho) { const int n = rho >> 4, i = rho & 15; return 8 * (i >> 2) + 4 * n + (i & 3); }

struct Unit { int pm, pn; };
struct Gemm { const bf16_t* A; const bf16_t* Bt; int M, N, K; };

struct StaticOrder {
    int nM, nN, nwg, G, c;
    __host__ __device__ void init(int M, int N, int G_, int c_) { nM = M / BM; nN = N / BM; nwg = nM * nN; G = G_; c = c_; }
    __host__ __device__ bool next(int i, Unit& u) const {
        const long L = (long)i * G + c; if (L >= nwg) return false;
        int wgid = (int)L; { const int q = nwg / NXCD, r = nwg % NXCD, xcd = wgid % NXCD, off = wgid / NXCD; wgid = (xcd < r ? xcd * (q + 1) : r * (q + 1) + (xcd - r) * q) + off; }
        const int nig = WGM * nN, gid = wgid / nig, fm = gid * WGM, gsz = (nM - fm) < WGM ? (nM - fm) : WGM;
        u.pm = fm + ((wgid % nig) % gsz); u.pn = (wgid % nig) / gsz; return true;
    }
    __device__ __forceinline__ void a_ready(const Unit&) const {}
    __device__ __forceinline__ void done(const Unit&) const {}
};

__device__ __forceinline__ unsigned cvt_pk_bf16(float lo, float hi) { unsigned r; asm volatile("v_cvt_pk_bf16_f32 %0, %1, %2" : "=v"(r) : "v"(lo), "v"(hi)); return r; }
typedef float f32x2 __attribute__((ext_vector_type(2)));
__device__ __forceinline__ f32x2 gelu_pk(f32x2 v) {
    const f32x2 av = __builtin_elementwise_abs(v), d = av * 0.2316418882f + 1.0f;
    f32x2 t; t.x = __builtin_amdgcn_rcpf(d.x); t.y = __builtin_amdgcn_rcpf(d.y);
    f32x2 q = t * 0.5307027145f + (-0.7265760135f); q = q * t + 0.7107068705f; q = q * t + (-0.142248368f); q = q * t + 0.127414796f; q = q * t;
    const f32x2 s = (v * v) * (-0.72134752044f);
    f32x2 e; e.x = __builtin_amdgcn_exp2f(s.x); e.y = __builtin_amdgcn_exp2f(s.y);
    const f32x2 m = v * (q * e), r = v - m;
    f32x2 o; o.x = v.x < 0.f ? m.x : r.x; o.y = v.y < 0.f ? m.y : r.y; return o;
}

template <int ACT  > struct EpiBf16 {
    static constexpr bool PERM = true, AFTER_DRAIN = false; static_assert(ACT == 0 || ACT == 1, "EpiBf16: ACT is 0 (none) or 1 (gelu_pk)");
    bf16_t* O; int ldc; const float* bias; int split_cols; size_t split_stride; float scale0;
    __device__ __forceinline__ void operator()(const f32x4 (&acc)[2][2][4][2], const Unit& u, int wr, int wc, int fr, int fq) const {
        const int row0 = u.pm * BM + wr * 64 + fr; int colt = u.pn * BM; bf16_t* base = O;
        float sc = 1.f; if (split_cols) { const int t = colt / split_cols; base += (size_t)t * split_stride; colt -= t * split_cols; if (t == 0) sc = scale0; }
        const int col0 = colt + wc * 32 + 8 * fq, bcol0 = u.pn * BM + wc * 32 + 8 * fq;
        f32x4 bv[2][2];
#pragma unroll
        for (int bj = 0; bj < 2; ++bj)
#pragma unroll
            for (int n = 0; n < 2; ++n) bv[bj][n] = bias ? *(const f32x4*)(bias + bcol0 + bj * HALF + 4 * n) : (f32x4){0.f, 0.f, 0.f, 0.f};
#pragma unroll
        for (int ai = 0; ai < 2; ++ai)
#pragma unroll
            for (int m = 0; m < 4; ++m) { bf16_t* rowp = base + (size_t)(row0 + ai * HALF + m * 16) * ldc + col0;
#pragma unroll
                for (int bj = 0; bj < 2; ++bj) { f32x4 v0 = acc[ai][bj][m][0] + bv[bj][0], v1 = acc[ai][bj][m][1] + bv[bj][1];
                    if (ACT == 1) { f32x2 a = gelu_pk((f32x2){v0[0], v0[1]}), b = gelu_pk((f32x2){v0[2], v0[3]}), c = gelu_pk((f32x2){v1[0], v1[1]}), d = gelu_pk((f32x2){v1[2], v1[3]});
                        v0 = (f32x4){a.x, a.y, b.x, b.y}; v1 = (f32x4){c.x, c.y, d.x, d.y}; }
                    v0 = v0 * sc; v1 = v1 * sc; u32x4 w; w.x = cvt_pk_bf16(v0[0], v0[1]); w.y = cvt_pk_bf16(v0[2], v0[3]); w.z = cvt_pk_bf16(v1[0], v1[1]); w.w = cvt_pk_bf16(v1[2], v1[3]);
                    *(u32x4*)(rowp + bj * HALF) = w; } }
    }
};

struct EpiResF32 {
    static constexpr bool PERM = false, AFTER_DRAIN = false;
    const float* base; float* out; int ldc;
    __device__ __forceinline__ void operator()(const f32x4 (&acc)[2][2][4][2], const Unit& u, int wr, int wc, int fr, int fq) const {
        const int row0 = u.pm * BM + wr * 64 + fr, col0 = u.pn * BM + wc * 32 + 4 * fq;
#pragma unroll
        for (int ai = 0; ai < 2; ++ai)
#pragma unroll
            for (int m = 0; m < 4; ++m) { const size_t off = (size_t)(row0 + ai * HALF + m * 16) * ldc + col0;
#pragma unroll
                for (int bj = 0; bj < 2; ++bj)
#pragma unroll
                    for (int n = 0; n < 2; ++n) *(f32x4*)(out + off + bj * HALF + n * 16) = *(const f32x4*)(base + off + bj * HALF + n * 16) + acc[ai][bj][m][n]; }
    }
};
__device__ __forceinline__ float sigmoid_fast(float x) { return __builtin_amdgcn_rcpf(1.0f + __builtin_amdgcn_exp2f(-1.4426950408889634f * x)); }
struct EpiSwiglu {
    static constexpr bool PERM = true, AFTER_DRAIN = false;
    bf16_t* ACT; const float* b_up;
    __device__ __forceinline__ void operator()(const f32x4 (&acc)[2][2][4][2], const Unit& u, int wr, int wc, int fr, int fq) const {
        const int e = u.pn >> 3, pnl = u.pn & 7;
        const int row0 = u.pm * BM + wr * 64 + fr, j0 = pnl * 128 + wc * 32 + 8 * fq;
        const float* bp = b_up + (size_t)e * 2048 + 2 * j0;
        const f32x4 b0 = *(const f32x4*)(bp), b1 = *(const f32x4*)(bp + 4), b2 = *(const f32x4*)(bp + 8), b3 = *(const f32x4*)(bp + 12);
        const float bg[8] = {b0[0], b0[2], b1[0], b1[2], b2[0], b2[2], b3[0], b3[2]};
        const float bl[8] = {b0[1], b0[3], b1[1], b1[3], b2[1], b2[3], b3[1], b3[3]};
#pragma unroll
        for (int ai = 0; ai < 2; ++ai)
#pragma unroll
            for (int m = 0; m < 4; ++m) {
                float o[8];
#pragma unroll
                for (int n = 0; n < 2; ++n)
#pragma unroll
                    for (int i = 0; i < 4; ++i) {
                        float g = acc[ai][0][m][n][i] + bg[4 * n + i], l = acc[ai][1][m][n][i] + bl[4 * n + i];
                        g = fminf(g, 7.0f); l = fminf(fmaxf(l, -7.0f), 7.0f);
                        o[4 * n + i] = g * sigmoid_fast(1.702f * g) * (l + 1.0f);
                    }
                u32x4 w; w.x = cvt_pk_bf16(o[0], o[1]); w.y = cvt_pk_bf16(o[2], o[3]); w.z = cvt_pk_bf16(o[4], o[5]); w.w = cvt_pk_bf16(o[6], o[7]);
                *(u32x4*)(ACT + (size_t)(row0 + ai * HALF + m * 16) * 1024 + j0) = w;
            }
    }
};
struct EpiDown {
    static constexpr bool PERM = true, AFTER_DRAIN = false;
    bf16_t* Y; const float* b_down; const float* row_gate;
    __device__ __forceinline__ void operator()(const f32x4 (&acc)[2][2][4][2], const Unit& u, int wr, int wc, int fr, int fq) const {
        const int e = u.pn >> 2, pnl = u.pn & 3;
        const int row0 = u.pm * BM + wr * 64 + fr, col0 = pnl * BM + wc * 32 + 8 * fq;
        f32x4 bv[2][2];
#pragma unroll
        for (int bj = 0; bj < 2; ++bj)
#pragma unroll
            for (int n = 0; n < 2; ++n) bv[bj][n] = *(const f32x4*)(b_down + (size_t)e * 1024 + col0 + bj * HALF + 4 * n);
#pragma unroll
        for (int ai = 0; ai < 2; ++ai)
#pragma unroll
            for (int m = 0; m < 4; ++m) { const int row = row0 + ai * HALF + m * 16; const float gt = row_gate[row];
#pragma unroll
                for (int bj = 0; bj < 2; ++bj) { const f32x4 v0 = (acc[ai][bj][m][0] + bv[bj][0]) * gt, v1 = (acc[ai][bj][m][1] + bv[bj][1]) * gt;
                    u32x4 w; w.x = cvt_pk_bf16(v0[0], v0[1]); w.y = cvt_pk_bf16(v0[2], v0[3]); w.z = cvt_pk_bf16(v1[0], v1[1]); w.w = cvt_pk_bf16(v1[2], v1[3]);
                    *(u32x4*)(Y + (size_t)row * 1024 + col0 + bj * HALF) = w; } }
    }
};
struct MoeOrder {
    int nNl, nunits, G, c; const PG8_LAS unsigned char* texp;
    __device__ __forceinline__ bool next(int i, Unit& u) const {
        const long L = (long)i * G + c; if (L >= nunits) return false;
        int wgid = (int)L; { const int q = nunits / NXCD, r = nunits % NXCD, xcd = wgid % NXCD, off = wgid / NXCD; wgid = (xcd < r ? xcd * (q + 1) : r * (q + 1) + (xcd - r) * q) + off; }
        const int rt = wgid / nNl, pnl = wgid - rt * nNl;
        u.pm = rt; u.pn = (int)texp[rt] * nNl + pnl; return true;
    }
    __device__ __forceinline__ void a_ready(const Unit&) const {}
    __device__ __forceinline__ void done(const Unit&) const {}
};
template <class Epi, class Sched, bool ALIGN_EPI = false, bool SP2 = false>
__device__ __forceinline__ void gemm_phase(PG8_LAS unsigned char* lds, const Gemm g, const Sched& S, const Epi& E) {
    const int tid = threadIdx.x, wid = __builtin_amdgcn_readfirstlane(tid >> 6), lane = tid & 63, wr = wid >> 2, wc = wid & 3, fr = lane & 15, fq = lane >> 4;
    const int K = g.K, nt = K / BK;
    unsigned voffA[2], voffB[2];
#pragma unroll
    for (int i = 0; i < 2; ++i) { int R, C; stage_rc(tid * 16 + i * 8192, R, C); const int Rb = Epi::PERM ? ((R & ~31) + perm32(R & 31)) : R;
        voffA[i] = (unsigned)(R * K + C) * 2u; voffB[i] = (unsigned)(Rb * K + C) * 2u; }
    const size_t kstep = (size_t)(BK * 2);
    const size_t hstep = (size_t)HALF * K * 2;
    const size_t tstep = 2 * hstep;
    const unsigned ldsw = (unsigned)wid * 1024u;
    const int aoff = lds_byte(wr * 64 + fr, fq * 8), boff = lds_byte(wc * 32 + fr, fq * 8);
#define PG8_SA(b, h) (((b) * 2 + (h)) * HTB)
#define PG8_SB(b, h) ((4 + (b) * 2 + (h)) * HTB)
#define PG8_STAGE(bufoff, gbase, voff) do { _Pragma("unroll") for (int _i = 0; _i < 2; ++_i) \
        __builtin_amdgcn_global_load_lds((const unsigned*)((const char*)(gbase) + (voff)[_i]), (PG8_LAS unsigned*)(lds + (bufoff) + ldsw + _i * 8192), 16, 0, 0); } while (0)
#define PG8_LDA(dst, b, h) do { _Pragma("unroll") for (int m = 0; m < 4; ++m) _Pragma("unroll") for (int k = 0; k < 2; ++k) dst[m][k] = *(const PG8_LAS bf16x8*)(lds + PG8_SA(b, h) + aoff + m * 2048 + k * 1024); } while (0)
#define PG8_LDB(dst, b, h) do { _Pragma("unroll") for (int n = 0; n < 2; ++n) _Pragma("unroll") for (int k = 0; k < 2; ++k) dst[n][k] = *(const PG8_LAS bf16x8*)(lds + PG8_SB(b, h) + boff + n * 2048 + k * 1024); } while (0)
#define PG8_MMA(ai, bj, At, Bt) do { __builtin_amdgcn_s_setprio(1); _Pragma("unroll") for (int m = 0; m < 4; ++m) _Pragma("unroll") for (int n = 0; n < 2; ++n) _Pragma("unroll") for (int k = 0; k < 2; ++k) \
        acc[ai][bj][m][n] = __builtin_amdgcn_mfma_f32_16x16x32_bf16(Bt[n][k], At[m][k], acc[ai][bj][m][n], 0, 0, 0); __builtin_amdgcn_s_setprio(0); } while (0)
#define PG8_WAIT_V(n) asm volatile("s_waitcnt vmcnt(" #n ")" ::: "memory")
#define PG8_WAIT_L(n) asm volatile("s_waitcnt lgkmcnt(" #n ")" ::: "memory")
#define PG8_BAR __builtin_amdgcn_s_barrier()
#define PG8_SCHED __builtin_amdgcn_sched_barrier(0)
    Unit cur, nxt; int ui = 0;
    if (!S.next(0, cur)) return;
    f32x4 acc[2][2][4][2];
#pragma unroll
    for (int a = 0; a < 2; ++a)
#pragma unroll
        for (int b = 0; b < 2; ++b)
#pragma unroll
            for (int m = 0; m < 4; ++m)
#pragma unroll
                for (int n = 0; n < 2; ++n) acc[a][b][m][n] = (f32x4){0.f, 0.f, 0.f, 0.f};
    bf16x8 At[4][2], B0[2][2], B1[2][2];
    const char* cA = (const char*)g.A + (size_t)cur.pm * tstep; const char* cB = (const char*)g.Bt + (size_t)cur.pn * tstep;
    S.a_ready(cur);
    if constexpr (SP2) {
        PG8_STAGE(PG8_SB(0, 0), cB, voffB); PG8_STAGE(PG8_SB(0, 1), cB + hstep, voffB); PG8_STAGE(PG8_SA(0, 0), cA, voffA); PG8_STAGE(PG8_SA(0, 1), cA + hstep, voffA);
        if (wr == 1) PG8_BAR;
        PG8_WAIT_V(2); PG8_BAR;
        PG8_STAGE(PG8_SB(1, 0), cB + kstep, voffB); PG8_STAGE(PG8_SA(1, 0), cA + kstep, voffA); PG8_STAGE(PG8_SB(1, 1), cB + hstep + kstep, voffB);
        PG8_WAIT_V(6); PG8_BAR;
    } else {
        PG8_STAGE(PG8_SB(0, 0), cB, voffB); PG8_STAGE(PG8_SA(0, 0), cA, voffA); PG8_STAGE(PG8_SB(0, 1), cB + hstep, voffB); PG8_STAGE(PG8_SA(0, 1), cA + hstep, voffA);
        if (wr == 1) PG8_BAR;
        PG8_WAIT_V(4); PG8_BAR;
        PG8_STAGE(PG8_SB(1, 0), cB + kstep, voffB); PG8_STAGE(PG8_SA(1, 0), cA + kstep, voffA); PG8_STAGE(PG8_SB(1, 1), cB + hstep + kstep, voffB);
        PG8_WAIT_V(6); PG8_BAR;
    }
    for (;;) {
        const bool has_next = S.next(ui + 1, nxt);
        const char* nA = has_next ? (const char*)g.A + (size_t)nxt.pm * tstep : cA; const char* nB = has_next ? (const char*)g.Bt + (size_t)nxt.pn * tstep : cB;
        for (int t = 0; t < nt; t += 2) {
            const bool last = (t == nt - 2);
            const char* a1 = cA + (size_t)(t + 1) * kstep;
            const char* a2 = last ? nA : cA + (size_t)(t + 2) * kstep; const char* b2 = last ? nB : cB + (size_t)(t + 2) * kstep;
            const char* a3 = a2 + kstep; const char* b3 = b2 + kstep;
            if (last && has_next) S.a_ready(nxt);
            if constexpr (SP2) {
            PG8_LDB(B0, 0, 0); PG8_LDB(B1, 0, 1); PG8_SCHED; PG8_LDA(At, 0, 0); PG8_STAGE(PG8_SA(1, 1), a1 + hstep, voffA);
            PG8_WAIT_V(8); PG8_WAIT_L(0); PG8_BAR; PG8_MMA(0, 0, At, B0); PG8_MMA(0, 1, At, B1); PG8_BAR; PG8_SCHED;
            PG8_LDA(At, 0, 1); PG8_STAGE(PG8_SB(0, 0), b2, voffB); PG8_STAGE(PG8_SB(0, 1), b2 + hstep, voffB); PG8_STAGE(PG8_SA(0, 0), a2, voffA);
            PG8_WAIT_V(8); PG8_WAIT_L(0); PG8_BAR; PG8_MMA(1, 0, At, B0); PG8_MMA(1, 1, At, B1); PG8_BAR; PG8_SCHED;
            PG8_LDB(B0, 1, 0); PG8_LDB(B1, 1, 1); PG8_SCHED; PG8_LDA(At, 1, 0); PG8_STAGE(PG8_SA(0, 1), a2 + hstep, voffA);
            PG8_WAIT_V(8); PG8_WAIT_L(0); PG8_BAR; PG8_MMA(0, 0, At, B0); PG8_MMA(0, 1, At, B1); PG8_BAR; PG8_SCHED;
            PG8_LDA(At, 1, 1); PG8_STAGE(PG8_SB(1, 0), b3, voffB); PG8_STAGE(PG8_SB(1, 1), b3 + hstep, voffB); PG8_STAGE(PG8_SA(1, 0), a3, voffA);
            PG8_WAIT_V(8); PG8_WAIT_L(0); PG8_BAR; PG8_MMA(1, 0, At, B0); PG8_MMA(1, 1, At, B1); PG8_BAR; PG8_SCHED;
            } else {
            PG8_LDB(B0, 0, 0); PG8_SCHED; PG8_LDA(At, 0, 0); PG8_STAGE(PG8_SA(1, 1), a1 + hstep, voffA);
            PG8_WAIT_L(8); PG8_BAR; PG8_WAIT_L(0); PG8_MMA(0, 0, At, B0); PG8_BAR; PG8_SCHED;
            PG8_LDB(B1, 0, 1); PG8_STAGE(PG8_SB(0, 0), b2, voffB);
            PG8_BAR; PG8_WAIT_L(0); PG8_MMA(0, 1, At, B1); PG8_BAR;
            PG8_LDA(At, 0, 1); PG8_STAGE(PG8_SA(0, 0), a2, voffA);
            PG8_BAR; PG8_WAIT_L(0); PG8_MMA(1, 0, At, B0); PG8_BAR; PG8_SCHED;
            PG8_STAGE(PG8_SB(0, 1), b2 + hstep, voffB);
            PG8_WAIT_V(6); PG8_BAR; PG8_MMA(1, 1, At, B1); PG8_BAR;
            PG8_LDB(B0, 1, 0); PG8_SCHED; PG8_LDA(At, 1, 0); PG8_STAGE(PG8_SA(0, 1), a2 + hstep, voffA);
            PG8_WAIT_L(8); PG8_BAR; PG8_WAIT_L(0); PG8_MMA(0, 0, At, B0); PG8_BAR; PG8_SCHED;
            PG8_LDB(B1, 1, 1); PG8_STAGE(PG8_SB(1, 0), b3, voffB);
            PG8_BAR; PG8_WAIT_L(0); PG8_MMA(0, 1, At, B1); PG8_BAR;
            PG8_LDA(At, 1, 1); PG8_STAGE(PG8_SA(1, 0), a3, voffA);
            PG8_BAR; PG8_WAIT_L(0); PG8_MMA(1, 0, At, B0); PG8_BAR; PG8_SCHED;
            PG8_STAGE(PG8_SB(1, 1), b3 + hstep, voffB);
            PG8_WAIT_V(6); PG8_BAR; PG8_MMA(1, 1, At, B1); PG8_BAR;
            }
        }
        if constexpr (ALIGN_EPI) { if (wr == 0) PG8_BAR; }
        if constexpr (!Epi::AFTER_DRAIN) { E(acc, cur, wr, wc, fr, fq); S.done(cur); }
        if (!has_next) break;
#pragma unroll
        for (int a = 0; a < 2; ++a)
#pragma unroll
            for (int b = 0; b < 2; ++b)
#pragma unroll
                for (int m = 0; m < 4; ++m)
#pragma unroll
                    for (int n = 0; n < 2; ++n) acc[a][b][m][n] = (f32x4){0.f, 0.f, 0.f, 0.f};
        cur = nxt; cA = nA; cB = nB; ++ui;
        if constexpr (ALIGN_EPI) { if (wr == 1) PG8_BAR; }
    }
    PG8_WAIT_V(0);
    if constexpr (!ALIGN_EPI) { if (wr == 0) PG8_BAR; }
    PG8_BAR;
    if constexpr (Epi::AFTER_DRAIN) { E.fused(acc, cur, wr, wc, fr, fq, lds, wid, lane); S.done(cur); }
#undef PG8_SA
#undef PG8_SB
#undef PG8_STAGE
#undef PG8_LDA
#undef PG8_LDB
#undef PG8_MMA
#undef PG8_WAIT_V
#undef PG8_WAIT_L
#undef PG8_BAR
#undef PG8_SCHED
}
}

constexpr int NWAVES = 8, NTHREADS = 512;
constexpr int BATCH = 2, SEQ = 8192, NTOK = BATCH * SEQ, DM = 1024, INC = 4096;
constexpr int NE = 32, TOPK = 4;
constexpr int PMAX = NTOK * TOPK + NE * 256;
constexpr int MAXTILES = PMAX / 256;
constexpr float EPS = 1e-6f;
constexpr int C_HQ = 0, C_HFF = 512, C_HFB = 1024, C_HI = 1536, C_HG = 2048, C_AQ = 2560, C_AK = 3072, C_AV = 3584;

#ifndef MK_PER_PHASE
#define MK_PER_PHASE 0
#endif
constexpr int NPHASE = 12;

constexpr size_t MiB = 1u << 20;
constexpr size_t WS_CTL = 0, CTL_ZERO_BYTES = 1 * MiB;
constexpr size_t WS_WIN = 2 * MiB, WS_WOUT = 10 * MiB, WS_WUP = 12 * MiB, WS_WDN = 140 * MiB;
constexpr size_t WS_XN = 204 * MiB, WS_PROJ = 236 * MiB, WS_CS = 364 * MiB, WS_QR = 368 * MiB, WS_KR = 384 * MiB;
constexpr size_t WS_MIX = 400 * MiB, WS_OF = 432 * MiB, WS_RT = 496 * MiB, WS_XS = 498 * MiB, WS_ACT = 642 * MiB, WS_END = 786 * MiB;
constexpr size_t RT_TOPE = 0, RT_TOPG = 256 * 1024, RT_SLOT = 512 * 1024, RT_HIST = 768 * 1024, RT_GATE = 1024 * 1024;
constexpr int CW_TMO = 0, CW_BAR = 4096;

constexpr int RING_BYTES = 131072;
constexpr int LDSCTL_OFF = RING_BYTES;
constexpr int MISC_OFF = LDSCTL_OFF;
constexpr int L_HIST = LDSCTL_OFF + 256;
constexpr int L_TOT = L_HIST + 128;
constexpr int L_MINE = L_TOT + 128;
constexpr int L_PADS = L_MINE + 128;
constexpr int L_TEXP = L_PADS + 256;
constexpr int L_ITE = L_TEXP + 512;
constexpr int L_ITP = L_ITE + 1024;
constexpr int L_HG = L_ITP + 1024;
constexpr int LDS_BYTES = 147456;
static_assert(L_HG + 12288 <= LDS_BYTES, "LDS map");

#define GAS __attribute__((address_space(1)))
#define LAS __attribute__((address_space(3)))
typedef unsigned short bf16;
typedef unsigned v4u __attribute__((ext_vector_type(4)));
typedef unsigned v2u __attribute__((ext_vector_type(2)));
typedef float f32x4 __attribute__((ext_vector_type(4)));
typedef GAS unsigned gu32;
#define RLX_AGENT __ATOMIC_RELAXED, __HIP_MEMORY_SCOPE_AGENT
#define LDS_WAIT() asm volatile("s_waitcnt lgkmcnt(0)" ::: "memory")
#define VM_WAIT() asm volatile("s_waitcnt vmcnt(0)" ::: "memory")
__device__ __forceinline__ unsigned f2bf(float f) { unsigned u = __builtin_bit_cast(unsigned, f); return (u + 0x7fffu + ((u >> 16) & 1u)) >> 16; }
__device__ __forceinline__ unsigned pk2(float lo, float hi) { return f2bf(lo) | (f2bf(hi) << 16); }
__device__ __forceinline__ float bf2f(unsigned b) { return __builtin_bit_cast(float, b << 16); }
__device__ __forceinline__ float bflo(unsigned w) { return __builtin_bit_cast(float, w << 16); }
__device__ __forceinline__ float bfhi(unsigned w) { return __builtin_bit_cast(float, w & 0xffff0000u); }
__device__ __forceinline__ float sigm(float x) { return __builtin_amdgcn_rcpf(1.0f + __builtin_amdgcn_exp2f(-1.4426950408889634f * x)); }

#define XB_TMO      128
#define XB_XCNT(j)  (256  + 64 * (j))
#define XB_XSUB(j)  (1280 + 64 * (j))
#define XB_XGEN(j)  (2304 + 64 * (j))
#define XB_TOP      3328
#define XB_TOPGEN   3392
#define XCD_BAR_WORDS 3456
#define XB_SPIN_CAP (1u << 23)
__device__ __forceinline__ unsigned xb_ld(unsigned* p)              { return __hip_atomic_load(p, __ATOMIC_RELAXED, __HIP_MEMORY_SCOPE_AGENT); }
__device__ __forceinline__ unsigned xb_add(unsigned* p, unsigned v) { return __hip_atomic_fetch_add(p, v, __ATOMIC_RELAXED, __HIP_MEMORY_SCOPE_AGENT); }
__device__ __forceinline__ unsigned xb_xcc_id() { return (unsigned)__builtin_amdgcn_s_getreg((3 << 11) | 20) & 0xFu; }
#define XB_SPIN(cond, bar) do { unsigned _sp = 0; while (cond) { __builtin_amdgcn_s_sleep(1); \
    if ((++_sp & 255u) == 0u) { if (xb_ld(&(bar)[XB_TMO])) break; if (_sp > XB_SPIN_CAP) { atomicAdd(&(bar)[XB_TMO], 1u); break; } } } } while (0)
struct XcdBarrier { unsigned* bar; unsigned x; volatile LAS unsigned* st; };
__device__ __forceinline__ XcdBarrier xcd_barrier_post(unsigned* bar, volatile LAS unsigned* st) {
    XcdBarrier b; b.bar = bar; b.x = xb_xcc_id(); b.st = st;
    if (threadIdx.x == 0) (void)xb_add(&bar[XB_XCNT(b.x)], 1u);
    return b;
}
__device__ __forceinline__ void xcd_barrier_complete(unsigned* bar, unsigned x, unsigned& nloc, unsigned& nx) {
    const unsigned G = gridDim.x * gridDim.y * gridDim.z;
    unsigned sum, cnt, mine, sp = 0u;
    for (;;) {
        sum = 0u; cnt = 0u; mine = 0u;
#pragma unroll
        for (unsigned j = 0; j < 16; ++j) { const unsigned c = xb_ld(&bar[XB_XCNT(j)]); sum += c; cnt += (c > 0u) ? 1u : 0u; mine = (j == x) ? c : mine; }
        if (sum == G) break;
        __builtin_amdgcn_s_sleep(1);
        if ((++sp & 255u) == 0u) { if (xb_ld(&bar[XB_TMO])) break; if (sp > XB_SPIN_CAP) { atomicAdd(&bar[XB_TMO], 1u); break; } }
    }
    nloc = mine > 0u ? mine : 1u; nx = cnt > 0u ? cnt : 1u;
}
__device__ __forceinline__ void xcd_barrier(const XcdBarrier& b) {
    asm volatile("s_waitcnt vmcnt(0)" ::: "memory");
    __syncthreads();
    if (threadIdx.x == 0) {
        unsigned* bar = b.bar;
        __builtin_amdgcn_s_waitcnt(0);
        unsigned nloc = b.st[0], nx = b.st[1];
        if (nloc == 0u) { xcd_barrier_complete(bar, b.x, nloc, nx); b.st[0] = nloc; b.st[1] = nx; }
        const unsigned old = xb_add(&bar[XB_XSUB(b.x)], 1u);
        const unsigned gen = old / nloc;
        if (old + 1u == (gen + 1u) * nloc) {
            __builtin_amdgcn_fence(__ATOMIC_RELEASE, "agent");
            asm volatile("s_waitcnt vmcnt(0)" ::: "memory");
            const unsigned og = xb_add(&bar[XB_TOP], 1u);
            const unsigned tg = og / nx;
            if (og + 1u == (tg + 1u) * nx) xb_add(&bar[XB_TOPGEN], 1u);
            else XB_SPIN(xb_ld(&bar[XB_TOPGEN]) == tg, bar);
            __builtin_amdgcn_fence(__ATOMIC_ACQUIRE, "agent");
            xb_add(&bar[XB_XGEN(b.x)], 1u);
            asm volatile("s_waitcnt vmcnt(0)" ::: "memory");
        } else {
            XB_SPIN(xb_ld(&bar[XB_XGEN(b.x)]) == gen, bar);
            __builtin_amdgcn_fence(__ATOMIC_ACQUIRE, "agent");
            asm volatile("s_waitcnt vmcnt(0)" ::: "memory");
        }
    }
    __syncthreads();
}

__device__ __forceinline__ float wave_sum(float v) {
#pragma unroll
    for (int o = 1; o < 64; o <<= 1) v += __shfl_xor(v, o);
    return v;
}

struct Args {
    const float* x; const int* pos; const float* g1; const float* w_in; const float* qg; const float* kg; const float* lb; const float* og;
    const float* w_out; const float* g2; const float* w_r; const float* b_r; const float* w_up; const float* b_up; const float* w_dn; const float* b_dn;
    float* out; unsigned char* ws; int ph_lo, ph_hi;
};

struct P0Item { const float* src; bf16* dst; int N; };
__device__ __forceinline__ P0Item p0_decode(const Args& a, int it, int& stride) {
    constexpr int I_UP = NE * 16 * 64, I_DN = NE * 16 * 32, I_IN = 16 * 128;
    bf16* Win_t = (bf16*)(a.ws + WS_WIN); bf16* Wout_t = (bf16*)(a.ws + WS_WOUT); bf16* Wup_t = (bf16*)(a.ws + WS_WUP); bf16* Wdn_t = (bf16*)(a.ws + WS_WDN);
    P0Item I; int r = it; stride = 1;
    if (r < I_UP) { const int e = r >> 10; r &= 1023; const int kb = r >> 6, q = r & 63, p = q & 1, j0 = (q >> 1) * 32; const int c0 = 256 * (j0 >> 7) + 128 * p + (j0 & 127);
        stride = 2; I.N = 2048; I.src = a.w_up + (size_t)e * 1024 * 2048 + (size_t)(kb * 64) * 2048 + 2 * j0 + p; I.dst = Wup_t + ((size_t)e * 2048 + c0) * 1024 + kb * 64; return I; }
    r -= I_UP;
    if (r < I_DN) { const int e = r >> 9; r &= 511; const int kb = r >> 5, nb = r & 31;
        I.N = 1024; I.src = a.w_dn + (size_t)e * 1024 * 1024 + (size_t)(kb * 64) * 1024 + nb * 32; I.dst = Wdn_t + ((size_t)e * 1024 + nb * 32) * 1024 + kb * 64; return I; }
    r -= I_DN;
    if (r < I_IN) { const int kb = r >> 7, nb = r & 127; I.N = INC; I.src = a.w_in + (size_t)(kb * 64) * INC + nb * 32; I.dst = Win_t + (size_t)(nb * 32) * 1024 + kb * 64; return I; }
    r -= I_IN;
    { const int kb = r >> 5, nb = r & 31; I.N = 1024; I.src = a.w_out + (size_t)(kb * 64) * 1024 + nb * 32; I.dst = Wout_t + (size_t)(nb * 32) * 1024 + kb * 64; return I; }
}
#define P0_LOAD(IT) do { int st_; const P0Item I_ = p0_decode(a, (IT), st_); const float* sp_ = I_.src + (size_t)(lane >> 5) * I_.N + st_ * (lane & 31); \
        _Pragma("unroll") for (int i = 0; i < 32; ++i) rr[i] = sp_[(size_t)(2 * i) * I_.N]; } while (0)
__device__ __forceinline__ void p0_prologue(const Args& a, LAS unsigned char* lds, int gw, int NGW, int lane, int wave) {
    LAS float* scr = (LAS float*)(lds + wave * 16384);
    constexpr int NITEMS = NE * 16 * 64 + NE * 16 * 32 + 16 * 128 + 16 * 32;
    float rr[32];
    if (gw < NITEMS) P0_LOAD(gw);
    for (int it = gw; it < NITEMS; it += NGW) {
        int st0; const P0Item I = p0_decode(a, it, st0);
#pragma unroll
        for (int i = 0; i < 32; ++i) scr[(2 * i + (lane >> 5)) * 33 + (lane & 31)] = rr[i];
        LDS_WAIT(); asm volatile("" ::: "memory");
        if (it + NGW < NITEMS) P0_LOAD(it + NGW);
        const int c = lane & 7;
#pragma unroll
        for (int j = 0; j < 4; ++j) { const int n = (lane >> 3) + 8 * j; const LAS float* sp = scr + (8 * c) * 33 + n;
            v4u o; o.x = pk2(sp[0 * 33], sp[1 * 33]); o.y = pk2(sp[2 * 33], sp[3 * 33]); o.z = pk2(sp[4 * 33], sp[5 * 33]); o.w = pk2(sp[6 * 33], sp[7 * 33]);
            *(GAS v4u*)(I.dst + (size_t)n * 1024 + 8 * c) = o; }
        LDS_WAIT(); asm volatile("" ::: "memory");
    }
    bf16* XN = (bf16*)(a.ws + WS_XN);
    f32x4 g[4];
#pragma unroll
    for (int j = 0; j < 4; ++j) g[j] = ((const f32x4*)a.g1)[64 * j + lane];
    for (int m = gw; m < NTOK; m += NGW) {
        const f32x4* xr = (const f32x4*)(a.x + (size_t)m * DM) + lane;
        f32x4 v[4]; float s = 0.f;
#pragma unroll
        for (int j = 0; j < 4; ++j) { v[j] = xr[64 * j]; s += (v[j].x * v[j].x + v[j].y * v[j].y) + (v[j].z * v[j].z + v[j].w * v[j].w); }
        const float rstd = __builtin_amdgcn_rsqf(wave_sum(s) * (1.0f / DM) + EPS);
        v2u* o8 = (v2u*)(XN + (size_t)m * DM) + lane;
#pragma unroll
        for (int j = 0; j < 4; ++j) { v2u w; w.x = pk2(v[j].x * rstd * g[j].x, v[j].y * rstd * g[j].y); w.y = pk2(v[j].z * rstd * g[j].z, v[j].w * rstd * g[j].w); o8[64 * j] = w; }
    }
    float* CS = (float*)(a.ws + WS_CS);
    for (int idx = gw * 64 + lane; idx < NTOK * 32; idx += NGW * 64) {
        const int tok = idx >> 5, i = idx & 31;
        const float inv = exp2f(-(float)i * 0.41524101186092029f);
        const float ang = (float)a.pos[tok] * inv;
        double r = (double)ang * 0.15915494309189535; r -= floor(r);
        const float rf = (float)r;
        CS[(size_t)tok * 64 + i] = __builtin_amdgcn_cosf(rf); CS[(size_t)tok * 64 + 32 + i] = __builtin_amdgcn_sinf(rf);
    }
}

__device__ __forceinline__ void p2_qkprep(const Args& a, int gw, int NGW, int lane) {
    const bf16* PROJ = (const bf16*)(a.ws + WS_PROJ); const float* CS = (const float*)(a.ws + WS_CS);
    const int c = lane & 7, ci = (c & 3) * 8;
    const f32x4 gq0 = *(const f32x4*)(a.qg + 8 * c), gq1 = *(const f32x4*)(a.qg + 8 * c + 4), gk0 = *(const f32x4*)(a.kg + 8 * c), gk1 = *(const f32x4*)(a.kg + 8 * c + 4);
    for (int tok = gw; tok < NTOK; tok += NGW) {
        const v4u wq = *(const v4u*)(PROJ + (size_t)tok * INC + C_AQ + lane * 8), wk = *(const v4u*)(PROJ + (size_t)tok * INC + C_AK + lane * 8);
        const f32x4 c0 = *(const f32x4*)(CS + (size_t)tok * 64 + ci), c1 = *(const f32x4*)(CS + (size_t)tok * 64 + ci + 4), s0 = *(const f32x4*)(CS + (size_t)tok * 64 + 32 + ci), s1 = *(const f32x4*)(CS + (size_t)tok * 64 + 32 + ci + 4);
        const float cs_[8] = {c0.x, c0.y, c0.z, c0.w, c1.x, c1.y, c1.z, c1.w}, sn_[8] = {s0.x, s0.y, s0.z, s0.w, s1.x, s1.y, s1.z, s1.w};
#pragma unroll
        for (int isk = 0; isk < 2; ++isk) {
            const v4u w = isk ? wk : wq; const f32x4 g0 = isk ? gk0 : gq0, g1 = isk ? gk1 : gq1;
            float x[8] = {bflo(w.x), bfhi(w.x), bflo(w.y), bfhi(w.y), bflo(w.z), bfhi(w.z), bflo(w.w), bfhi(w.w)};
            const float gg[8] = {g0.x, g0.y, g0.z, g0.w, g1.x, g1.y, g1.z, g1.w};
            float ss = 0.f;
#pragma unroll
            for (int j = 0; j < 8; ++j) ss += x[j] * x[j];
            ss += __shfl_xor(ss, 1); ss += __shfl_xor(ss, 2); ss += __shfl_xor(ss, 4);
            const float rstd = __builtin_amdgcn_rsqf(ss * (1.0f / 64.0f) + EPS) * (isk ? 1.0f : 0.125f * 1.4426950408889634f);
            float o[8];
#pragma unroll
            for (int j = 0; j < 8; ++j) { const float y = x[j] * rstd * gg[j]; const float yp = __shfl_xor(y, 4);
                o[j] = (c < 4) ? (y * cs_[j] - yp * sn_[j]) : (y * cs_[j] + yp * sn_[j]); }
            v4u ow; ow.x = pk2(o[0], o[1]); ow.y = pk2(o[2], o[3]); ow.z = pk2(o[4], o[5]); ow.w = pk2(o[6], o[7]);
            *(v4u*)((bf16*)(a.ws + (isk ? WS_KR : WS_QR)) + (size_t)tok * 512 + lane * 8) = ow;
        }
    }
}

__device__ __forceinline__ void p6_router(const Args& a, LAS unsigned char* lds, int tid, int lane, int wave) {
    LAS float* WrT = (LAS float*)lds;
    LAS int* lhist = (LAS int*)(lds + L_HIST);
    for (int idx = tid; idx < 32768; idx += NTHREADS) { const int k = idx >> 5, e = idx & 31; WrT[e * 1024 + k] = a.w_r[idx]; }
    if (tid < 32) lhist[tid] = 0;
    __syncthreads();
    bf16* XN = (bf16*)(a.ws + WS_XN);
    int* tope = (int*)(a.ws + WS_RT + RT_TOPE); float* topg = (float*)(a.ws + WS_RT + RT_TOPG); int* hist = (int*)(a.ws + WS_RT + RT_HIST);
    f32x4 g[4];
#pragma unroll
    for (int j = 0; j < 4; ++j) g[j] = ((const f32x4*)a.g2)[64 * j + lane];
    const float br = a.b_r[lane & 31];
    for (int blk = (int)blockIdx.x; blk < NTOK / 64; blk += (int)gridDim.x) {
        for (int rr = 0; rr < 8; ++rr) {
            const int row = blk * 64 + wave * 8 + rr;
            const f32x4* xr = (const f32x4*)(a.out + (size_t)row * DM) + lane;
            f32x4 v[4]; float s = 0.f;
#pragma unroll
            for (int j = 0; j < 4; ++j) { v[j] = xr[64 * j]; s += (v[j].x * v[j].x + v[j].y * v[j].y) + (v[j].z * v[j].z + v[j].w * v[j].w); }
            const float rstd = __builtin_amdgcn_rsqf(wave_sum(s) * (1.0f / DM) + EPS);
            v2u* o8 = (v2u*)(XN + (size_t)row * DM) + lane;
#pragma unroll
            for (int j = 0; j < 4; ++j) { v[j] = v[j] * rstd * g[j]; v2u w; w.x = pk2(v[j].x, v[j].y); w.y = pk2(v[j].z, v[j].w); o8[64 * j] = w; }
            float vals[32];
#pragma unroll
            for (int e = 0; e < 32; ++e) { float p = 0.f;
#pragma unroll
                for (int j = 0; j < 4; ++j) { const f32x4 w = *(const LAS f32x4*)(WrT + e * 1024 + 256 * j + 4 * lane); p += (v[j].x * w.x + v[j].y * w.y) + (v[j].z * w.z + v[j].w * w.w); }
                vals[e] = p; }
#pragma unroll
            for (int sft = 0; sft < 5; ++sft) { const int msk = 1 << sft; const bool up = (lane & msk) != 0;
#pragma unroll
                for (int i = 0; i < (16 >> sft); ++i) { const float lo = vals[2 * i], hi = vals[2 * i + 1]; const float send = up ? lo : hi, keep = up ? hi : lo; vals[i] = keep + __shfl_xor(send, msk); } }
            float logit = vals[0] + __shfl_xor(vals[0], 32) + br;
            int myi = lane & 31; float tv[4]; int ti[4]; float cur = logit;
#pragma unroll
            for (int k = 0; k < 4; ++k) { float bv = cur; int bi = myi;
#pragma unroll
                for (int o = 1; o < 32; o <<= 1) { const float ov = __shfl_xor(bv, o); const int oi = __shfl_xor(bi, o); if (ov > bv || (ov == bv && oi < bi)) { bv = ov; bi = oi; } }
                tv[k] = bv; ti[k] = bi; if (myi == bi) cur = -3.0e38f; }
            const float e1 = __expf(tv[1] - tv[0]), e2 = __expf(tv[2] - tv[0]), e3 = __expf(tv[3] - tv[0]); const float inv = 1.0f / (1.0f + e1 + e2 + e3);
            if (lane < 4) { const int ee = lane == 0 ? ti[0] : lane == 1 ? ti[1] : lane == 2 ? ti[2] : ti[3]; const float gg = (lane == 0 ? 1.0f : lane == 1 ? e1 : lane == 2 ? e2 : e3) * inv;
                tope[row * 4 + lane] = ee; topg[row * 4 + lane] = gg; __hip_atomic_fetch_add(&lhist[ee], 1, __ATOMIC_RELAXED, __HIP_MEMORY_SCOPE_WORKGROUP); }
        }
        __syncthreads();
        if (tid < 32) { hist[blk * 32 + tid] = lhist[tid]; lhist[tid] = 0; }
        __syncthreads();
    }
}

__device__ __forceinline__ void moe_tables(const Args& a, LAS unsigned char* lds, int tid, int blk) {
    const int* hist = (const int*)(a.ws + WS_RT + RT_HIST);
    LAS int* tot = (LAS int*)(lds + L_TOT); LAS int* mine = (LAS int*)(lds + L_MINE); LAS int* pads = (LAS int*)(lds + L_PADS); LAS unsigned char* texp = (LAS unsigned char*)(lds + L_TEXP);
    LAS int* part = (LAS int*)lds;
    { const int e = tid & 31, pt = tid >> 5; int t = 0, m = 0;
#pragma unroll
      for (int q = 0; q < 16; ++q) { const int b2 = pt * 16 + q; const int hv = hist[b2 * 32 + e]; t += hv; m += (b2 < blk) ? hv : 0; }
      part[pt * 32 + e] = t; part[512 + pt * 32 + e] = m; }
    __syncthreads();
    if (tid < 32) { int t = 0, m = 0;
#pragma unroll
      for (int q = 0; q < 16; ++q) { t += part[q * 32 + tid]; m += part[512 + q * 32 + tid]; }
      tot[tid] = t; mine[tid] = m; }
    __syncthreads();
    if (tid == 0) { int ps = 0, nt = 0;
#pragma unroll 1
        for (int e = 0; e < 32; ++e) { pads[e] = ps; const int tl = (tot[e] + 255) >> 8;
#pragma unroll 1
            for (int q = 0; q < tl; ++q) texp[nt + q] = (unsigned char)e;
            nt += tl; ps += tl * 256; } pads[32] = nt; }
    __syncthreads();
}

__device__ __forceinline__ void p7_gather(const Args& a, LAS unsigned char* lds, int tid, int lane, int wave) {
    const int* tope = (const int*)(a.ws + WS_RT + RT_TOPE); const float* topg = (const float*)(a.ws + WS_RT + RT_TOPG);
    int* slot = (int*)(a.ws + WS_RT + RT_SLOT); float* rgate = (float*)(a.ws + WS_RT + RT_GATE);
    const bf16* XN = (const bf16*)(a.ws + WS_XN); bf16* XS = (bf16*)(a.ws + WS_XS);
    LAS int* mine = (LAS int*)(lds + L_MINE); LAS int* pads = (LAS int*)(lds + L_PADS); LAS int* ite = (LAS int*)(lds + L_ITE); LAS int* itp = (LAS int*)(lds + L_ITP);
    for (int blk = (int)blockIdx.x; blk < NTOK / 64; blk += (int)gridDim.x) {
        moe_tables(a, lds, tid, blk);
        if (tid < 256) ite[tid] = tope[blk * 256 + tid];
        __syncthreads();
        if (tid < 32) { int rk = pads[tid] + mine[tid];
#pragma unroll 1
            for (int i = 0; i < 256; ++i) if (ite[i] == tid) itp[i] = rk++; }
        __syncthreads();
        if (tid < 256) { const int p = itp[tid]; slot[blk * 256 + tid] = p; rgate[p] = topg[blk * 256 + tid]; }
        for (int i = wave; i < 256; i += NWAVES) { const int p = itp[i]; const int row = blk * 64 + (i >> 2);
            const v4u* s = (const v4u*)(XN + (size_t)row * DM); v4u* d = (v4u*)(XS + (size_t)p * DM); d[lane] = s[lane]; d[lane + 64] = s[lane + 64]; }
        __syncthreads();
    }
}

__device__ __forceinline__ void p10_combine(const Args& a, int gw, int NGW, int lane) {
    const int* slot = (const int*)(a.ws + WS_RT + RT_SLOT); const bf16* Y = (const bf16*)(a.ws + WS_XS);
    for (int tok = gw; tok < NTOK; tok += NGW) {
        const int r0 = slot[tok * 4], r1 = slot[tok * 4 + 1], r2 = slot[tok * 4 + 2], r3 = slot[tok * 4 + 3];
        f32x4* o = (f32x4*)(a.out + (size_t)tok * DM) + lane;
#pragma unroll
        for (int j = 0; j < 4; ++j) { f32x4 v = o[64 * j];
            const v2u y0 = ((const v2u*)(Y + (size_t)r0 * DM))[64 * j + lane], y1 = ((const v2u*)(Y + (size_t)r1 * DM))[64 * j + lane], y2 = ((const v2u*)(Y + (size_t)r2 * DM))[64 * j + lane], y3 = ((const v2u*)(Y + (size_t)r3 * DM))[64 * j + lane];
            v.x += (bflo(y0.x) + bflo(y1.x)) + (bflo(y2.x) + bflo(y3.x)); v.y += (bfhi(y0.x) + bfhi(y1.x)) + (bfhi(y2.x) + bfhi(y3.x));
            v.z += (bflo(y0.y) + bflo(y1.y)) + (bflo(y2.y) + bflo(y3.y)); v.w += (bfhi(y0.y) + bfhi(y1.y)) + (bfhi(y2.y) + bfhi(y3.y));
            o[64 * j] = v; }
    }
}


typedef float f32x16 __attribute__((ext_vector_type(16)));
typedef short bf16x8 __attribute__((ext_vector_type(8)));
typedef short s16x4 __attribute__((ext_vector_type(4)));
typedef float f32x2_t __attribute__((ext_vector_type(2)));
typedef __bf16 bf16x2_t __attribute__((ext_vector_type(2)));
__device__ __forceinline__ int crow(int r, int hi) { return (r & 3) + 8 * (r >> 2) + 4 * hi; }
__device__ __forceinline__ unsigned cvtpk(float lo, float hi) { f32x2_t v = {lo, hi}; bf16x2_t b = __builtin_convertvector(v, bf16x2_t); return __builtin_bit_cast(unsigned, b); }
__device__ __forceinline__ s16x4 vtr(const LAS unsigned char* p) { return __builtin_bit_cast(s16x4, __builtin_amdgcn_ds_read_tr16_b64_v4i16((LAS s16x4*)p)); }
#define VFRAG(lo, hi) (bf16x8){lo[0], lo[1], lo[2], lo[3], hi[0], hi[1], hi[2], hi[3]}
__device__ __forceinline__ bf16x8 pfrag(const f32x16& s, int b) { v4u w; w.x = cvtpk(s[b], s[b + 1]); w.y = cvtpk(s[b + 2], s[b + 3]); w.z = cvtpk(s[b + 4], s[b + 5]); w.w = cvtpk(s[b + 6], s[b + 7]); return __builtin_bit_cast(bf16x8, w); }

constexpr size_t WS_US = 432 * MiB;
constexpr size_t WS_OP = 786 * MiB;
constexpr size_t WS_AD = 834 * MiB;
constexpr size_t WS_LP = 835 * MiB;
constexpr size_t WS_END2 = 838 * MiB;

__device__ __forceinline__ void attn_unit(const Args& a, LAS unsigned char* wl, int wu, int lane, float Bl2) {
    const bf16* PROJ = (const bf16*)(a.ws + WS_PROJ); const bf16* QR = (const bf16*)(a.ws + WS_QR); const bf16* KR = (const bf16*)(a.ws + WS_KR);
    const int tile = wu & 255, r_ = wu >> 8, p = r_ % 3, bh = r_ / 3, b = bh >> 3, h = bh & 7;
    const int dsh = 2 * p, dil = 1 << dsh, tpr = 256 >> dsh, r = tile >> (8 - dsh), l0 = (tile & (tpr - 1)) * 32, L = SEQ >> dsh;
    const int r32 = lane & 31, hi = lane >> 5;
    const size_t tb = (size_t)b * SEQ + r;
    bf16x8 qf[4];
    { const bf16* qp = QR + (tb + (size_t)(l0 + r32) * dil) * 512 + h * 64 + hi * 8;
#pragma unroll
      for (int d0 = 0; d0 < 4; ++d0) qf[d0] = *(const bf16x8*)(qp + d0 * 16); }
    f32x16 o0, o1;
#pragma unroll
    for (int i = 0; i < 16; ++i) { o0[i] = 0.f; o1[i] = 0.f; }
    float lsum = 0.f;
    const LAS unsigned char* vb = wl + (4 * hi + ((lane & 15) >> 2)) * 64 + ((lane >> 4) & 1) * 32 + (lane & 3) * 8;
    bf16x8 kf[2][4]; v4u vv[2][4];
#define ATT_LOAD(KT, BUF) do { const int kb_ = l0 - 64 + 32 * (KT); int lk_ = kb_ + r32; lk_ = lk_ < 0 ? 0 : (lk_ >= L ? L - 1 : lk_); \
        const bf16* kp_ = KR + (tb + (size_t)lk_ * dil) * 512 + h * 64 + hi * 8; \
        _Pragma("unroll") for (int d0 = 0; d0 < 4; ++d0) kf[BUF][d0] = *(const bf16x8*)(kp_ + d0 * 16); \
        _Pragma("unroll") for (int i = 0; i < 4; ++i) { int lv_ = kb_ + 8 * i + (lane >> 3); lv_ = lv_ < 0 ? 0 : (lv_ >= L ? L - 1 : lv_); \
            vv[BUF][i] = *(const v4u*)(PROJ + (tb + (size_t)lv_ * dil) * INC + C_AV + h * 64 + (lane & 7) * 8); } } while (0)
    ATT_LOAD(0, 0);
#pragma unroll
    for (int kt = 0; kt < 5; ++kt) {
        if (kt < 4) ATT_LOAD(kt + 1, (kt + 1) & 1);
        const int kb = l0 - 64 + 32 * kt;
        if (!(kb + 31 < 0 || kb >= L)) {
#pragma unroll
        for (int i = 0; i < 4; ++i) { const int kr = 8 * i + (lane >> 3), c = lane & 7; *(LAS v4u*)(wl + (c >> 2) * 2048 + (kr >> 3) * 512 + (kr & 7) * 64 + (c & 3) * 16) = vv[kt & 1][i]; }
        f32x16 s;
#pragma unroll
        for (int i = 0; i < 16; ++i) s[i] = 0.f;
#pragma unroll
        for (int d0 = 0; d0 < 4; ++d0) s = __builtin_amdgcn_mfma_f32_32x32x16_bf16(kf[kt & 1][d0], qf[d0], s, 0, 0, 0);
#pragma unroll
        for (int rg = 0; rg < 16; ++rg) { const int key = kb + crow(rg, hi), dq = key - (l0 + r32);
            const bool ok = (dq >= -64) && (dq <= 64) && (key >= 0) && (key < L);
            const float pe = ok ? __builtin_amdgcn_exp2f(s[rg] - Bl2) : 0.f; lsum += pe; s[rg] = pe; }
        const bf16x8 pw0 = pfrag(s, 0), pw1 = pfrag(s, 8);
        { const s16x4 a0 = vtr(vb), a1 = vtr(vb + 512), b0 = vtr(vb + 1024), b1 = vtr(vb + 1536);
          o0 = __builtin_amdgcn_mfma_f32_32x32x16_bf16(pw0, VFRAG(a0, a1), o0, 0, 0, 0); o0 = __builtin_amdgcn_mfma_f32_32x32x16_bf16(pw1, VFRAG(b0, b1), o0, 0, 0, 0); }
        { const s16x4 a0 = vtr(vb + 2048), a1 = vtr(vb + 2048 + 512), b0 = vtr(vb + 2048 + 1024), b1 = vtr(vb + 2048 + 1536);
          o1 = __builtin_amdgcn_mfma_f32_32x32x16_bf16(pw0, VFRAG(a0, a1), o1, 0, 0, 0); o1 = __builtin_amdgcn_mfma_f32_32x32x16_bf16(pw1, VFRAG(b0, b1), o1, 0, 0, 0); }
        }
    }
#undef ATT_LOAD
    lsum += __shfl_xor(lsum, 32);
    float* LP = (float*)(a.ws + WS_LP) + (size_t)p * NTOK * 8;
    if (hi == 0) LP[(tb + (size_t)(l0 + r32) * dil) * 8 + h] = lsum;
    LAS bf16* stg = (LAS bf16*)wl;
#pragma unroll
    for (int rg = 0; rg < 16; ++rg) { const int orow = crow(rg, hi); stg[orow * 64 + r32] = (bf16)f2bf(o0[rg]); stg[orow * 64 + 32 + r32] = (bf16)f2bf(o1[rg]); }
    bf16* OP = (bf16*)(a.ws + WS_OP) + (size_t)p * NTOK * 512;
#pragma unroll
    for (int i = 0; i < 4; ++i) { const int row = 8 * i + (lane >> 3), ch = lane & 7; const v4u v = *(const LAS v4u*)(wl + row * 128 + ch * 16);
        *(v4u*)(OP + (tb + (size_t)(l0 + row) * dil) * 512 + h * 64 + ch * 8) = v; }
}
__device__ __forceinline__ float attn_bound_l2(const Args& a, int lane) {
    float mq = fabsf(a.qg[lane]), mk = fabsf(a.kg[lane]);
#pragma unroll
    for (int o = 1; o < 64; o <<= 1) { mq = fmaxf(mq, __shfl_xor(mq, o)); mk = fmaxf(mk, __shfl_xor(mk, o)); }
    return 8.0f * mq * mk * 1.4426950408889634f + 0.5f;
}
__device__ __forceinline__ void p3_attn(const Args& a, LAS unsigned char* lds, int lane, int wave) {
    const float Bl2 = attn_bound_l2(a, lane);
    LAS unsigned char* wl = lds + 98304 + wave * 4096;
    for (int bu = (int)blockIdx.x; bu < BATCH * 8 * 3 * 256 / 8; bu += (int)gridDim.x) attn_unit(a, wl, bu * 8 + wave, lane, Bl2);
}

__device__ __forceinline__ int vt_off(int row, int col) { return (col >> 5) * 4096 + (row >> 3) * 512 + (row & 7) * 64 + (col & 31) * 2; }
__device__ __forceinline__ int sw_off(int row, int col) { return row * 272 + col * 2; }
constexpr int H_V = 0, H_TOT = 16384, H_ZF = 18432, H_ZB = 35840, H_QR = 53248, H_QTF = 70656, H_QTB = 88064, H_KUT = 53248;
struct HgTiles { v4u zf[2], zb[2], v[2], q[2], hg[2]; };
template <bool FULL> __device__ __forceinline__ void hg_issue(const bf16* PROJ, int item, int tid, HgTiles& T) {
    const int bh = item >> 7, n = item & 127, b = bh >> 2, h = bh & 3; const size_t t0 = (size_t)b * SEQ + 64 * n;
#pragma unroll
    for (int i = 0; i < 2; ++i) { const int idx = tid + 512 * i, row = idx >> 4, ch = idx & 15; const bf16* rp = PROJ + (t0 + row) * INC + h * 128 + ch * 8;
        T.zf[i] = *(const v4u*)(rp + C_HFF); T.zb[i] = *(const v4u*)(rp + C_HFB); T.v[i] = *(const v4u*)(rp + C_HI); if (FULL) T.q[i] = *(const v4u*)(rp + C_HQ); }
    if (FULL) { const int row = tid >> 3, seg = tid & 7; const bf16* rp = PROJ + (t0 + row) * INC + C_HG + h * 128 + 16 * seg; T.hg[0] = *(const v4u*)rp; T.hg[1] = *(const v4u*)(rp + 8); }
}
template <bool FULL> __device__ __forceinline__ void hg_write(LAS unsigned char* lds, int tid, const HgTiles& T) {
#pragma unroll
    for (int i = 0; i < 2; ++i) { const int idx = tid + 512 * i, row = idx >> 4, ch = idx & 15; const int so = sw_off(row, ch * 8);
        *(LAS v4u*)(lds + H_ZF + so) = T.zf[i]; *(LAS v4u*)(lds + H_ZB + so) = T.zb[i]; *(LAS v4u*)(lds + H_V + vt_off(row, ch * 8)) = T.v[i]; if (FULL) *(LAS v4u*)(lds + H_QR + so) = T.q[i]; }
}
#define HG_PASS1(KDECL, KSTORE) \
    const int dir = tid >> 8, half = (tid >> 7) & 1, d = tid & 127; \
    LAS float* tot = (LAS float*)(lds + H_TOT); \
    const float la0 = a.lb[dir * 512 + h * 128 + d], la1 = a.lb[1024 + dir * 512 + h * 128 + d]; \
    const float lbv = 1.0f / (1.0f + __expf(la1 - la0)), oml = 1.0f - lbv; \
    float g[32]; KDECL; \
    { LAS unsigned char* zt = lds + (dir ? H_ZB : H_ZF); float tsum = 0.f; \
      _Pragma("unroll") for (int i = 0; i < 32; ++i) { const int so_ = sw_off(half * 32 + i, d); const float z = bf2f(*(const LAS bf16*)(zt + so_)); const float sg = sigm(z); const float f = lbv + oml * sg; g[i] = __logf(f); const float kv_ = oml * (1.0f - sg); KSTORE; tsum += g[i]; } \
      tot[(dir * 2 + half) * 128 + d] = tsum; } \
    __syncthreads(); \
    const float tother = tot[(dir * 2 + (half ^ 1)) * 128 + d];

__device__ __forceinline__ void hg_summary_phase(const Args& a, LAS unsigned char* lds, int tid, int lane, int wave) {
    const bf16* PROJ = (const bf16*)(a.ws + WS_PROJ);
    const int G = gridDim.x; int item = blockIdx.x; if (item >= 1024) return;
    HgTiles T; hg_issue<false>(PROJ, item, tid, T);
    for (; item < 1024; item += G) {
        const int bh = item >> 7, n = item & 127, b = bh >> 2, h = bh & 3;
        hg_write<false>(lds, tid, T);
        __syncthreads();
        if (item + G < 1024) hg_issue<false>(PROJ, item + G, tid, T);
        LAS unsigned char* kut = lds + H_KUT;
        HG_PASS1(float kk[32], kk[i] = kv_);
        { unsigned pk[16];
          if (dir == 0) { float run = half ? 0.f : tother;
#pragma unroll
              for (int i = 31; i >= 0; --i) { const float v = kk[i] * __expf(run); run += g[i]; if (i & 1) pk[i >> 1] = f2bf(v) << 16; else pk[i >> 1] |= f2bf(v); } }
          else { float run = half ? tother : 0.f;
#pragma unroll
              for (int i = 0; i < 32; ++i) { const float v = kk[i] * __expf(run); run += g[i]; if (i & 1) pk[i >> 1] |= f2bf(v) << 16; else pk[i >> 1] = f2bf(v); } }
          LAS unsigned char* rowp = kut + (dir * 128 + d) * 144 + half * 64;
#pragma unroll
          for (int j = 0; j < 4; ++j) { v4u w; w.x = pk[4 * j]; w.y = pk[4 * j + 1]; w.z = pk[4 * j + 2]; w.w = pk[4 * j + 3]; *(LAS v4u*)(rowp + 16 * j) = w; }
          if (half == 0) ((float*)(a.ws + WS_AD))[(((size_t)dir * 8 + bh) * 128 + n) * 128 + d] = __expf(tother + tot[(dir * 2) * 128 + d]);
        }
        __syncthreads();
        { const int wdir = wave >> 2, rt = wave & 3, r32 = lane & 31, hi = lane >> 5;
          bf16x8 af[4];
#pragma unroll
          for (int ks = 0; ks < 4; ++ks) af[ks] = *(const LAS bf16x8*)(kut + (wdir * 128 + 32 * rt + r32) * 144 + (16 * ks + 8 * hi) * 2);
          bf16* UT = (bf16*)(a.ws + WS_US) + ((((size_t)wdir * 8 + bh) * 128 + n) << 14);
          const int q = (lane & 15) >> 2, pp = lane & 3, g1 = (lane >> 4) & 1;
#pragma unroll
          for (int ct = 0; ct < 4; ++ct) { f32x16 acc;
#pragma unroll
              for (int i = 0; i < 16; ++i) acc[i] = 0.f;
#pragma unroll
              for (int ks = 0; ks < 4; ++ks) { const int row = 16 * ks + 8 * hi + q, col = 32 * ct + 16 * g1 + 4 * pp;
                  const s16x4 lo = vtr(lds + H_V + vt_off(row, col)), hh = vtr(lds + H_V + vt_off(row + 4, col));
                  acc = __builtin_amdgcn_mfma_f32_32x32x16_bf16(af[ks], VFRAG(lo, hh), acc, 0, 0, 0); }
              bf16* up = UT + (size_t)(32 * ct + r32) * 128 + 32 * rt + 4 * hi;
#pragma unroll
              for (int q4 = 0; q4 < 4; ++q4) { v2u w; w.x = cvtpk(acc[4 * q4], acc[4 * q4 + 1]); w.y = cvtpk(acc[4 * q4 + 2], acc[4 * q4 + 3]); *(v2u*)(up + 8 * q4) = w; } }
        }
        __syncthreads();
    }
}
__device__ __forceinline__ void hg_scan(const Args& a, int gtid, int NGT) {
    for (int idx = gtid; idx < 16 * 8192; idx += NGT) {
        const int chain = idx >> 13, e2 = idx & 8191, dk = (2 * e2) & 127, dir = chain >> 3;
        unsigned* U = (unsigned*)(a.ws + WS_US) + ((size_t)chain * 128 << 13) + e2;
        const float* AD = (const float*)(a.ws + WS_AD) + (size_t)chain * 128 * 128 + dk;
        float r0 = 0.f, r1 = 0.f;
#pragma unroll 8
        for (int st = 0; st < 128; ++st) { const int n = dir ? 127 - st : st;
            const unsigned u = U[(size_t)n << 13]; const f32x2_t av = *(const f32x2_t*)(AD + n * 128);
            U[(size_t)n << 13] = pk2(r0, r1);
            r0 = av.x * r0 + bflo(u); r1 = av.y * r1 + bfhi(u); }
    }
}
__device__ __forceinline__ void hg_output_phase(const Args& a, LAS unsigned char* lds, int tid, int lane, int wave) {
    const bf16* PROJ = (const bf16*)(a.ws + WS_PROJ);
    const int G = gridDim.x; int item = blockIdx.x; if (item >= 1024) return;
    HgTiles T; hg_issue<true>(PROJ, item, tid, T);
    const int ct = wave & 1, dvt = wave >> 1, r32 = lane & 31, hi = lane >> 5;
    for (; item < 1024; item += G) {
        const int bh = item >> 7, n = item & 127, b = bh >> 2, h = bh & 3; const size_t t0 = (size_t)b * SEQ + 64 * n;
        hg_write<true>(lds, tid, T);
        const v4u hg0 = T.hg[0], hg1 = T.hg[1];
        __syncthreads();
        if (item + G < 1024) hg_issue<true>(PROJ, item + G, tid, T);
        bf16x8 sf0[8], sf1[8];
        const bf16* ST0 = (const bf16*)(a.ws + WS_US) + ((((size_t)0 * 8 + bh) * 128 + n) << 14) + (size_t)(32 * dvt + r32) * 128 + 8 * hi;
        const bf16* ST1 = ST0 + ((size_t)8 * 128 << 14);
#pragma unroll
        for (int kd = 0; kd < 8; ++kd) sf0[kd] = *(const bf16x8*)(ST0 + 16 * kd);
        HG_PASS1(, *(LAS bf16*)(zt + so_) = (bf16)f2bf(kv_));
        { LAS unsigned char* qt = lds + (dir ? H_QTB : H_QTF); LAS unsigned char* kt = lds + (dir ? H_ZB : H_ZF); const LAS unsigned char* qr_ = lds + H_QR;
          if (dir == 0) { float run = half ? tother : 0.f;
#pragma unroll
              for (int i = 0; i < 32; ++i) { run += g[i]; const int c = half * 32 + i, so = sw_off(c, d); const float qr = bf2f(*(const LAS bf16*)(qr_ + so)); const float qv = qr * sigm(qr);
                  *(LAS bf16*)(qt + so) = (bf16)f2bf(qv * __expf(run)); *(LAS bf16*)(kt + so) = (bf16)f2bf(bf2f(*(const LAS bf16*)(kt + so)) * __expf(-run)); } }
          else { float run = half ? 0.f : tother;
#pragma unroll
              for (int i = 31; i >= 0; --i) { run += g[i]; const int c = half * 32 + i, so = sw_off(c, d); const float qr = bf2f(*(const LAS bf16*)(qr_ + so)); const float qv = qr * sigm(qr);
                  *(LAS bf16*)(qt + so) = (bf16)f2bf(qv * __expf(run)); *(LAS bf16*)(kt + so) = (bf16)f2bf(bf2f(*(const LAS bf16*)(kt + so)) * __expf(-run)); } }
        }
        __syncthreads();
        f32x16 o;
#pragma unroll
        for (int i = 0; i < 16; ++i) o[i] = 0.f;
#pragma unroll
        for (int kd = 0; kd < 8; ++kd) sf1[kd] = *(const bf16x8*)(ST1 + 16 * kd);
        { const int q = (lane & 15) >> 2, pp = lane & 3, g1 = (lane >> 4) & 1;
#pragma unroll
          for (int dr = 0; dr < 2; ++dr) {
              const LAS unsigned char* qt = lds + (dr ? H_QTB : H_QTF); const LAS unsigned char* kt = lds + (dr ? H_ZB : H_ZF);
              bf16x8 qf[8];
#pragma unroll
              for (int kd = 0; kd < 8; ++kd) qf[kd] = *(const LAS bf16x8*)(qt + sw_off(32 * ct + r32, 16 * kd + 8 * hi));
#pragma unroll
              for (int st = 0; st < 2; ++st) {
                  if (dr == 0 ? (st > ct) : (st < ct)) continue;
                  f32x16 x;
#pragma unroll
                  for (int i = 0; i < 16; ++i) x[i] = 0.f;
#pragma unroll
                  for (int kd = 0; kd < 8; ++kd) { const bf16x8 kf = *(const LAS bf16x8*)(kt + sw_off(32 * st + r32, 16 * kd + 8 * hi)); x = __builtin_amdgcn_mfma_f32_32x32x16_bf16(kf, qf[kd], x, 0, 0, 0); }
                  if (st == ct) {
#pragma unroll
                      for (int rg = 0; rg < 16; ++rg) { const int s_ = crow(rg, hi); const bool keep = dr == 0 ? (s_ <= r32) : (s_ >= r32); x[rg] = keep ? x[rg] : 0.f; } }
                  const bf16x8 pw0 = pfrag(x, 0), pw1 = pfrag(x, 8);
                  const int col = 32 * dvt + 16 * g1 + 4 * pp;
                  { const int row = 32 * st + 4 * hi + q; const s16x4 lo = vtr(lds + H_V + vt_off(row, col)), hh = vtr(lds + H_V + vt_off(row + 8, col));
                    o = __builtin_amdgcn_mfma_f32_32x32x16_bf16(pw0, VFRAG(lo, hh), o, 0, 0, 0); }
                  { const int row = 32 * st + 16 + 4 * hi + q; const s16x4 lo = vtr(lds + H_V + vt_off(row, col)), hh = vtr(lds + H_V + vt_off(row + 8, col));
                    o = __builtin_amdgcn_mfma_f32_32x32x16_bf16(pw1, VFRAG(lo, hh), o, 0, 0, 0); }
              }
#pragma unroll
              for (int kd = 0; kd < 8; ++kd) o = __builtin_amdgcn_mfma_f32_32x32x16_bf16(qf[kd], dr ? sf1[kd] : sf0[kd], o, 0, 0, 0);
          } }
        __syncthreads();
        LAS float* stg = (LAS float*)(lds + H_QTF);
#pragma unroll
        for (int rg = 0; rg < 16; ++rg) stg[(32 * ct + crow(rg, hi)) * 132 + 32 * dvt + r32] = o[rg];
        __syncthreads();
        { const int row = tid >> 3, seg = tid & 7; const LAS float* sp = stg + row * 132 + 16 * seg; float v[16]; float ss = 0.f;
#pragma unroll
          for (int j = 0; j < 4; ++j) { const f32x4 w = *(const LAS f32x4*)(sp + 4 * j); v[4 * j] = w.x; v[4 * j + 1] = w.y; v[4 * j + 2] = w.z; v[4 * j + 3] = w.w; ss += (w.x * w.x + w.y * w.y) + (w.z * w.z + w.w * w.w); }
          ss += __shfl_xor(ss, 1); ss += __shfl_xor(ss, 2); ss += __shfl_xor(ss, 4);
          const float rstd = __builtin_amdgcn_rsqf(ss * (1.0f / 128.0f) + EPS);
          const float hg[16] = {bflo(hg0.x), bfhi(hg0.x), bflo(hg0.y), bfhi(hg0.y), bflo(hg0.z), bfhi(hg0.z), bflo(hg0.w), bfhi(hg0.w), bflo(hg1.x), bfhi(hg1.x), bflo(hg1.y), bfhi(hg1.y), bflo(hg1.z), bfhi(hg1.z), bflo(hg1.w), bfhi(hg1.w)};
          float r[16];
#pragma unroll
          for (int j = 0; j < 16; ++j) r[j] = v[j] * rstd * a.og[16 * seg + j] * hg[j] * sigm(hg[j]);
          v4u w0, w1; w0.x = pk2(r[0], r[1]); w0.y = pk2(r[2], r[3]); w0.z = pk2(r[4], r[5]); w0.w = pk2(r[6], r[7]); w1.x = pk2(r[8], r[9]); w1.y = pk2(r[10], r[11]); w1.z = pk2(r[12], r[13]); w1.w = pk2(r[14], r[15]);
          bf16* mp = (bf16*)(a.ws + WS_MIX) + (t0 + row) * 1024 + h * 128 + 16 * seg; *(v4u*)mp = w0; *(v4u*)(mp + 8) = w1; }
    }
}
__device__ __forceinline__ void attn_merge(const Args& a, int gw, int NGW, int lane) {
    const bf16* OP = (const bf16*)(a.ws + WS_OP); const float* LP = (const float*)(a.ws + WS_LP); bf16* MIX = (bf16*)(a.ws + WS_MIX);
    for (int tok = gw; tok < NTOK; tok += NGW) {
        float acc[8] = {0.f, 0.f, 0.f, 0.f, 0.f, 0.f, 0.f, 0.f}; float l = 0.f;
#pragma unroll
        for (int p = 0; p < 3; ++p) { const v4u w = *(const v4u*)(OP + ((size_t)p * NTOK + tok) * 512 + lane * 8); l += LP[((size_t)p * NTOK + tok) * 8 + (lane >> 3)];
            acc[0] += bflo(w.x); acc[1] += bfhi(w.x); acc[2] += bflo(w.y); acc[3] += bfhi(w.y); acc[4] += bflo(w.z); acc[5] += bfhi(w.z); acc[6] += bflo(w.w); acc[7] += bfhi(w.w); }
        const float il = 1.0f / l; v4u w; w.x = pk2(acc[0] * il, acc[1] * il); w.y = pk2(acc[2] * il, acc[3] * il); w.z = pk2(acc[4] * il, acc[5] * il); w.w = pk2(acc[6] * il, acc[7] * il);
        *(v4u*)(MIX + (size_t)tok * 1024 + 512 + lane * 8) = w;
    }
}

__global__ void __launch_bounds__(NTHREADS, 2) mk_fwd(Args a) {
    extern __shared__ __attribute__((aligned(16))) unsigned char lds_raw[];
    LAS unsigned char* lds = (LAS unsigned char*)lds_raw;
    const int tid = threadIdx.x, lane = tid & 63, wave = __builtin_amdgcn_readfirstlane(tid >> 6);
    const int G = gridDim.x, bx = blockIdx.x;
    const int vcu = (G % 8 == 0) ? (bx % 8) * (G / 8) + bx / 8 : bx;
    const int gw = vcu * NWAVES + wave, NGW = G * NWAVES, gtid = bx * NTHREADS + tid, NGT = G * NTHREADS;
    unsigned* ctl = (unsigned*)(a.ws + WS_CTL);
    for (int u = tid; u < (LDS_BYTES - LDSCTL_OFF) / 4; u += NTHREADS) ((LAS unsigned*)(lds + LDSCTL_OFF))[u] = 0u;
    __syncthreads();
    XcdBarrier bar; bar.bar = ctl + CW_BAR; bar.x = 0; bar.st = nullptr;
    if (!MK_PER_PHASE) bar = xcd_barrier_post(ctl + CW_BAR, (volatile LAS unsigned*)(lds + MISC_OFF) + 8);
    const int lo = a.ph_lo, hi = a.ph_hi;
#ifndef PH_MASK
#define PH_MASK 0xfff
#endif
#define IN(k) (((PH_MASK >> (k)) & 1) && lo <= (k) && (k) < hi)
#ifndef PROBE_PH
#define PROBE_PH -1
#endif
#define REP(k) for (int _r = 0; _r < ((PROBE_PH == (k)) ? 2 : 1); ++_r)
#define SEAM(k) do { if (IN(k) && IN((k) + 1)) xcd_barrier(bar); } while (0)

    if (IN(0)) REP(0) { p0_prologue(a, lds, gw, NGW, lane, wave); } SEAM(0);
    if (IN(1)) REP(1) {
        pg8::Gemm g{(const pg8::bf16_t*)(a.ws + WS_XN), (const pg8::bf16_t*)(a.ws + WS_WIN), NTOK, INC, DM}; pg8::StaticOrder S; S.init(NTOK, INC, G, bx);
        pg8::EpiBf16<0> E{(pg8::bf16_t*)(a.ws + WS_PROJ), INC, nullptr, 0, 0, 1.f};
        pg8::gemm_phase<pg8::EpiBf16<0>, pg8::StaticOrder, true, true>(lds, g, S, E);
    } SEAM(1);
    if (IN(2)) REP(2) { p2_qkprep(a, gw, NGW, lane); } SEAM(2);
    if (IN(3)) REP(3) { p3_attn(a, lds, lane, wave);
        hg_summary_phase(a, lds, tid, lane, wave);
    } SEAM(3);
    if (IN(4)) REP(4) {
        hg_scan(a, gtid, NGT);
    } SEAM(4);
    if (IN(5)) REP(5) {
        hg_output_phase(a, lds, tid, lane, wave);
        attn_merge(a, gw, NGW, lane);
    } SEAM(5);
    if (IN(6)) REP(6) {
        pg8::Gemm g{(const pg8::bf16_t*)(a.ws + WS_MIX), (const pg8::bf16_t*)(a.ws + WS_WOUT), NTOK, DM, DM}; pg8::StaticOrder S; S.init(NTOK, DM, G, bx);
        pg8::EpiResF32 E{a.x, a.out, DM};
        pg8::gemm_phase<pg8::EpiResF32, pg8::StaticOrder, true, true>(lds, g, S, E);
    } SEAM(6);
    if (IN(7)) REP(7) { p6_router(a, lds, tid, lane, wave); } SEAM(7);
    if (IN(8)) REP(8) { p7_gather(a, lds, tid, lane, wave); } SEAM(8);
    if (IN(9)) REP(9) {
        if (lo == 9) moe_tables(a, lds, tid, 0);
        const int ntiles = ((LAS int*)(lds + L_PADS))[32];
        pg8::Gemm g{(const pg8::bf16_t*)(a.ws + WS_XS), (const pg8::bf16_t*)(a.ws + WS_WUP), PMAX, 2048, DM};
        pg8::MoeOrder S{8, ntiles * 8, G, bx, (const LAS unsigned char*)(lds + L_TEXP)};
        pg8::EpiSwiglu E{(pg8::bf16_t*)(a.ws + WS_ACT), a.b_up};
        pg8::gemm_phase<pg8::EpiSwiglu, pg8::MoeOrder, true, true>(lds, g, S, E);
    } SEAM(9);
    if (IN(10)) REP(10) {
        if (lo == 10) moe_tables(a, lds, tid, 0);
        const int ntiles = ((LAS int*)(lds + L_PADS))[32];
        pg8::Gemm g{(const pg8::bf16_t*)(a.ws + WS_ACT), (const pg8::bf16_t*)(a.ws + WS_WDN), PMAX, 1024, DM};
        pg8::MoeOrder S{4, ntiles * 4, G, bx, (const LAS unsigned char*)(lds + L_TEXP)};
        pg8::EpiDown E{(pg8::bf16_t*)(a.ws + WS_XS), a.b_dn, (const float*)(a.ws + WS_RT + RT_GATE)};
        pg8::gemm_phase<pg8::EpiDown, pg8::MoeOrder, true, true>(lds, g, S, E);
    } SEAM(10);
    if (IN(11)) REP(11) { p10_combine(a, gw, NGW, lane); }
#undef IN
#undef SEAM
}

extern "C" void kernel_launch(void* const* d_in, const int* in_sizes, int n_in, void* d_out, int out_size, void* d_ws, size_t ws_size, hipStream_t stream) {
    static int grid = 0;
    if (grid == 0) {
        if (n_in != 16 || in_sizes[0] != NTOK * DM || out_size != NTOK * DM || ws_size < WS_END2) { fprintf(stderr, "kernel_launch: unexpected shapes / workspace (%d inputs, ws %zu)\n", n_in, ws_size); grid = -1; return; }
        int dev = 0, cus = 0;
        if (hipGetDevice(&dev) != hipSuccess || hipDeviceGetAttribute(&cus, hipDeviceAttributeMultiprocessorCount, dev) != hipSuccess) { grid = -1; return; }
        if (hipFuncSetAttribute((const void*)mk_fwd, hipFuncAttributeMaxDynamicSharedMemorySize, LDS_BYTES) != hipSuccess) { fprintf(stderr, "kernel_launch: hipFuncSetAttribute failed\n"); grid = -1; return; }
        (void)hipGetLastError();
        grid = cus;
    }
    if (grid < 0) return;
    if (hipMemsetAsync((char*)d_ws + WS_CTL, 0, CTL_ZERO_BYTES, stream) != hipSuccess) return;
    Args a{};
    a.x = (const float*)d_in[0]; a.pos = (const int*)d_in[1]; a.g1 = (const float*)d_in[2]; a.w_in = (const float*)d_in[3]; a.qg = (const float*)d_in[4]; a.kg = (const float*)d_in[5];
    a.lb = (const float*)d_in[6]; a.og = (const float*)d_in[7]; a.w_out = (const float*)d_in[8]; a.g2 = (const float*)d_in[9]; a.w_r = (const float*)d_in[10]; a.b_r = (const float*)d_in[11];
    a.w_up = (const float*)d_in[12]; a.b_up = (const float*)d_in[13]; a.w_dn = (const float*)d_in[14]; a.b_dn = (const float*)d_in[15];
    a.out = (float*)d_out; a.ws = (unsigned char*)d_ws;
#if MK_PER_PHASE
    for (int p = 0; p < NPHASE; ++p) { a.ph_lo = p; a.ph_hi = p + 1;
        hipLaunchKernelGGL(mk_fwd, dim3(grid), dim3(NTHREADS), LDS_BYTES, stream, a);
    }
#else
    a.ph_lo = 0; a.ph_hi = NPHASE; hipLaunchKernelGGL(mk_fwd, dim3(grid), dim3(NTHREADS), LDS_BYTES, stream, a);
#endif
}
```

```cpp
#include <hip/hip_runtime.h>
#include <cstdio>
#include <cstdint>
namespace pg8 {
#define PG8_LAS __attribute__((address_space(3)))
typedef unsigned short bf16_t;
typedef short bf16x8 __attribute__((ext_vector_type(8)));
typedef float f32x4 __attribute__((ext_vector_type(4)));
typedef unsigned u32x4 __attribute__((ext_vector_type(4)));
constexpr int BM = 256, BK = 64, HALF = 128, HTB = HALF * BK * 2  , STAGE_BYTES = 8 * HTB, NXCD = 8, WGM = 8;

__host__ __device__ __forceinline__ int lds_byte(int r, int c) { const int st = (r >> 4) * 2 + (c >> 5), rr = r & 15, cc = c & 31, ob = rr * 64 + cc * 2; return st * 1024 + (ob ^ (((ob >> 9) & 1) << 5)); }
__host__ __device__ __forceinline__ void stage_rc(int b, int& R, int& C) { const int st = b / 1024, sb = b % 1024, swz = sb ^ (((sb >> 9) & 1) << 5); R = (st >> 1) * 16 + swz / 64; C = (st & 1) * 32 + (swz % 64) / 2; }
__host__ __device__ __forceinline__ int perm32(int rho) { const int n = rho >> 4, i = rho & 15; return 8 * (i >> 2) + 4 * n + (i & 3); }

struct Unit { int pm, pn; };
struct Gemm { const bf16_t* A; const bf16_t* Bt; int M, N, K; };

struct StaticOrder {
    int nM, nN, nwg, G, c;
    __host__ __device__ void init(int M, int N, int G_, int c_) { nM = M / BM; nN = N / BM; nwg = nM * nN; G = G_; c = c_; }
    __host__ __device__ bool next(int i, Unit& u) const {
        const long L = (long)i * G + c; if (L >= nwg) return false;
        int wgid = (int)L; { const int q = nwg / NXCD, r = nwg % NXCD, xcd = wgid % NXCD, off = wgid / NXCD; wgid = (xcd < r ? xcd * (q + 1) : r * (q + 1) + (xcd - r) * q) + off; }
        const int nig = WGM * nN, gid = wgid / nig, fm = gid * WGM, gsz = (nM - fm) < WGM ? (nM - fm) : WGM;
        u.pm = fm + ((wgid % nig) % gsz); u.pn = (wgid % nig) / gsz; return true;
    }
    __device__ __forceinline__ void a_ready(const Unit&) const {}
    __device__ __forceinline__ void done(const Unit&) const {}
};

__device__ __forceinline__ unsigned cvt_pk_bf16(float lo, float hi) { unsigned r; asm volatile("v_cvt_pk_bf16_f32 %0, %1, %2" : "=v"(r) : "v"(lo), "v"(hi)); return r; }
typedef float f32x2 __attribute__((ext_vector_type(2)));
__device__ __forceinline__ f32x2 gelu_pk(f32x2 v) {
    const f32x2 av = __builtin_elementwise_abs(v), d = av * 0.2316418882f + 1.0f;
    f32x2 t; t.x = __builtin_amdgcn_rcpf(d.x); t.y = __builtin_amdgcn_rcpf(d.y);
    f32x2 q = t * 0.5307027145f + (-0.7265760135f); q = q * t + 0.7107068705f; q = q * t + (-0.142248368f); q = q * t + 0.127414796f; q = q * t;
    const f32x2 s = (v * v) * (-0.72134752044f);
    f32x2 e; e.x = __builtin_amdgcn_exp2f(s.x); e.y = __builtin_amdgcn_exp2f(s.y);
    const f32x2 m = v * (q * e), r = v - m;
    f32x2 o; o.x = v.x < 0.f ? m.x : r.x; o.y = v.y < 0.f ? m.y : r.y; return o;
}

template <int ACT  > struct EpiBf16 {
    static constexpr bool PERM = true, AFTER_DRAIN = false; static_assert(ACT == 0 || ACT == 1, "EpiBf16: ACT is 0 (none) or 1 (gelu_pk)");
    bf16_t* O; int ldc; const float* bias; int split_cols; size_t split_stride; float scale0;
    __device__ __forceinline__ void operator()(const f32x4 (&acc)[2][2][4][2], const Unit& u, int wr, int wc, int fr, int fq) const {
        const int row0 = u.pm * BM + wr * 64 + fr; int colt = u.pn * BM; bf16_t* base = O;
        float sc = 1.f; if (split_cols) { const int t = colt / split_cols; base += (size_t)t * split_stride; colt -= t * split_cols; if (t == 0) sc = scale0; }
        const int col0 = colt + wc * 32 + 8 * fq, bcol0 = u.pn * BM + wc * 32 + 8 * fq;
        f32x4 bv[2][2];
#pragma unroll
        for (int bj = 0; bj < 2; ++bj)
#pragma unroll
            for (int n = 0; n < 2; ++n) bv[bj][n] = bias ? *(const f32x4*)(bias + bcol0 + bj * HALF + 4 * n) : (f32x4){0.f, 0.f, 0.f, 0.f};
#pragma unroll
        for (int ai = 0; ai < 2; ++ai)
#pragma unroll
            for (int m = 0; m < 4; ++m) { bf16_t* rowp = base + (size_t)(row0 + ai * HALF + m * 16) * ldc + col0;
#pragma unroll
                for (int bj = 0; bj < 2; ++bj) { f32x4 v0 = acc[ai][bj][m][0] + bv[bj][0], v1 = acc[ai][bj][m][1] + bv[bj][1];
                    if (ACT == 1) { f32x2 a = gelu_pk((f32x2){v0[0], v0[1]}), b = gelu_pk((f32x2){v0[2], v0[3]}), c = gelu_pk((f32x2){v1[0], v1[1]}), d = gelu_pk((f32x2){v1[2], v1[3]});
                        v0 = (f32x4){a.x, a.y, b.x, b.y}; v1 = (f32x4){c.x, c.y, d.x, d.y}; }
                    v0 = v0 * sc; v1 = v1 * sc; u32x4 w; w.x = cvt_pk_bf16(v0[0], v0[1]); w.y = cvt_pk_bf16(v0[2], v0[3]); w.z = cvt_pk_bf16(v1[0], v1[1]); w.w = cvt_pk_bf16(v1[2], v1[3]);
                    *(u32x4*)(rowp + bj * HALF) = w; } }
    }
};

struct EpiResF32 {
    static constexpr bool PERM = false, AFTER_DRAIN = false;
    const float* base; float* out; int ldc;
    __device__ __forceinline__ void operator()(const f32x4 (&acc)[2][2][4][2], const Unit& u, int wr, int wc, int fr, int fq) const {
        const int row0 = u.pm * BM + wr * 64 + fr, col0 = u.pn * BM + wc * 32 + 4 * fq;
#pragma unroll
        for (int ai = 0; ai < 2; ++ai)
#pragma unroll
            for (int m = 0; m < 4; ++m) { const size_t off = (size_t)(row0 + ai * HALF + m * 16) * ldc + col0;
#pragma unroll
                for (int bj = 0; bj < 2; ++bj)
#pragma unroll
                    for (int n = 0; n < 2; ++n) *(f32x4*)(out + off + bj * HALF + n * 16) = *(const f32x4*)(base + off + bj * HALF + n * 16) + acc[ai][bj][m][n]; }
    }
};
__device__ __forceinline__ float sigmoid_fast(float x) { return __builtin_amdgcn_rcpf(1.0f + __builtin_amdgcn_exp2f(-1.4426950408889634f * x)); }
struct EpiSwiglu {
    static constexpr bool PERM = true, AFTER_DRAIN = false;
    bf16_t* ACT; const float* b_up;
    __device__ __forceinline__ void operator()(const f32x4 (&acc)[2][2][4][2], const Unit& u, int wr, int wc, int fr, int fq) const {
        const int e = u.pn >> 3, pnl = u.pn & 7;
        const int row0 = u.pm * BM + wr * 64 + fr, j0 = pnl * 128 + wc * 32 + 8 * fq;
        const float* bp = b_up + (size_t)e * 2048 + 2 * j0;
        const f32x4 b0 = *(const f32x4*)(bp), b1 = *(const f32x4*)(bp + 4), b2 = *(const f32x4*)(bp + 8), b3 = *(const f32x4*)(bp + 12);
        const float bg[8] = {b0[0], b0[2], b1[0], b1[2], b2[0], b2[2], b3[0], b3[2]};
        const float bl[8] = {b0[1], b0[3], b1[1], b1[3], b2[1], b2[3], b3[1], b3[3]};
#pragma unroll
        for (int ai = 0; ai < 2; ++ai)
#pragma unroll
            for (int m = 0; m < 4; ++m) {
                float o[8];
#pragma unroll
                for (int n = 0; n < 2; ++n)
#pragma unroll
                    for (int i = 0; i < 4; ++i) {
                        float g = acc[ai][0][m][n][i] + bg[4 * n + i], l = acc[ai][1][m][n][i] + bl[4 * n + i];
                        g = fminf(g, 7.0f); l = fminf(fmaxf(l, -7.0f), 7.0f);
                        o[4 * n + i] = g * sigmoid_fast(1.702f * g) * (l + 1.0f);
                    }
                u32x4 w; w.x = cvt_pk_bf16(o[0], o[1]); w.y = cvt_pk_bf16(o[2], o[3]); w.z = cvt_pk_bf16(o[4], o[5]); w.w = cvt_pk_bf16(o[6], o[7]);
                *(u32x4*)(ACT + (size_t)(row0 + ai * HALF + m * 16) * 1024 + j0) = w;
            }
    }
};
struct EpiDown {
    static constexpr bool PERM = true, AFTER_DRAIN = false;
    bf16_t* Y; const float* b_down; const float* row_gate;
    __device__ __forceinline__ void operator()(const f32x4 (&acc)[2][2][4][2], const Unit& u, int wr, int wc, int fr, int fq) const {
        const int e = u.pn >> 2, pnl = u.pn & 3;
        const int row0 = u.pm * BM + wr * 64 + fr, col0 = pnl * BM + wc * 32 + 8 * fq;
        f32x4 bv[2][2];
#pragma unroll
        for (int bj = 0; bj < 2; ++bj)
#pragma unroll
            for (int n = 0; n < 2; ++n) bv[bj][n] = *(const f32x4*)(b_down + (size_t)e * 1024 + col0 + bj * HALF + 4 * n);
#pragma unroll
        for (int ai = 0; ai < 2; ++ai)
#pragma unroll
            for (int m = 0; m < 4; ++m) { const int row = row0 + ai * HALF + m * 16; const float gt = row_gate[row];
#pragma unroll
                for (int bj = 0; bj < 2; ++bj) { const f32x4 v0 = (acc[ai][bj][m][0] + bv[bj][0]) * gt, v1 = (acc[ai][bj][m][1] + bv[bj][1]) * gt;
                    u32x4 w; w.x = cvt_pk_bf16(v0[0], v0[1]); w.y = cvt_pk_bf16(v0[2], v0[3]); w.z = cvt_pk_bf16(v1[0], v1[1]); w.w = cvt_pk_bf16(v1[2], v1[3]);
                    *(u32x4*)(Y + (size_t)row * 1024 + col0 + bj * HALF) = w; } }
    }
};
struct EpiProj {
    static constexpr bool PERM = true, AFTER_DRAIN = false;
    bf16_t* O; const float* lbs;
    __device__ __forceinline__ void operator()(const f32x4 (&acc)[2][2][4][2], const Unit& u, int wr, int wc, int fr, int fq) const {
        const int type = u.pn >> 1, row0 = u.pm * BM + wr * 64 + fr, col0 = u.pn * BM + wc * 32 + 8 * fq;
        const bool is_gate = (type == 1 || type == 2), is_silu = (type == 0 || type == 4);
        float lb[2][8];
#pragma unroll
        for (int bj = 0; bj < 2; ++bj) { const float* lp = lbs + (type == 2 ? 512 : 0) + (u.pn & 1) * 256 + wc * 32 + 8 * fq + bj * HALF;
            f32x4 l0 = {0.f, 0.f, 0.f, 0.f}, l1 = {0.f, 0.f, 0.f, 0.f}; if (is_gate) { l0 = *(const f32x4*)lp; l1 = *(const f32x4*)(lp + 4); }
            lb[bj][0] = l0[0]; lb[bj][1] = l0[1]; lb[bj][2] = l0[2]; lb[bj][3] = l0[3]; lb[bj][4] = l1[0]; lb[bj][5] = l1[1]; lb[bj][6] = l1[2]; lb[bj][7] = l1[3]; }
#pragma unroll
        for (int ai = 0; ai < 2; ++ai)
#pragma unroll
            for (int m = 0; m < 4; ++m) { bf16_t* rowp = O + (size_t)(row0 + ai * HALF + m * 16) * 4096 + col0;
#pragma unroll
                for (int bj = 0; bj < 2; ++bj) { float v[8];
#pragma unroll
                    for (int i = 0; i < 8; ++i) { const float x = acc[ai][bj][m][i >> 2][i & 3];
                        if (is_silu) v[i] = x * sigmoid_fast(x);
                        else if (is_gate) v[i] = __logf(lb[bj][i] + (1.0f - lb[bj][i]) * sigmoid_fast(x));
                        else v[i] = x; }
                    u32x4 w; w.x = cvt_pk_bf16(v[0], v[1]); w.y = cvt_pk_bf16(v[2], v[3]); w.z = cvt_pk_bf16(v[4], v[5]); w.w = cvt_pk_bf16(v[6], v[7]);
                    *(u32x4*)(rowp + bj * HALF) = w; } }
    }
};
struct MoeOrder {
    int nNl, nunits, G, c; const PG8_LAS unsigned char* texp;
    __device__ __forceinline__ bool next(int i, Unit& u) const {
        const long L = (long)i * G + c; if (L >= nunits) return false;
        int wgid = (int)L; { const int q = nunits / NXCD, r = nunits % NXCD, xcd = wgid % NXCD, off = wgid / NXCD; wgid = (xcd < r ? xcd * (q + 1) : r * (q + 1) + (xcd - r) * q) + off; }
        const int rt = wgid / nNl, pnl = wgid - rt * nNl;
        u.pm = rt; u.pn = (int)texp[rt] * nNl + pnl; return true;
    }
    __device__ __forceinline__ void a_ready(const Unit&) const {}
    __device__ __forceinline__ void done(const Unit&) const {}
};
template <class Epi, class Sched, bool ALIGN_EPI = false, bool SP2 = false>
__device__ __forceinline__ void gemm_phase(PG8_LAS unsigned char* lds, const Gemm g, const Sched& S, const Epi& E) {
    const int tid = threadIdx.x, wid = __builtin_amdgcn_readfirstlane(tid >> 6), lane = tid & 63, wr = wid >> 2, wc = wid & 3, fr = lane & 15, fq = lane >> 4;
    const int K = g.K, nt = K / BK;
    unsigned voffA[2], voffB[2];
#pragma unroll
    for (int i = 0; i < 2; ++i) { int R, C; stage_rc(tid * 16 + i * 8192, R, C); const int Rb = Epi::PERM ? ((R & ~31) + perm32(R & 31)) : R;
        voffA[i] = (unsigned)(R * K + C) * 2u; voffB[i] = (unsigned)(Rb * K + C) * 2u; }
    const size_t kstep = (size_t)(BK * 2);
    const size_t hstep = (size_t)HALF * K * 2;
    const size_t tstep = 2 * hstep;
    const unsigned ldsw = (unsigned)wid * 1024u;
    const int aoff = lds_byte(wr * 64 + fr, fq * 8), boff = lds_byte(wc * 32 + fr, fq * 8);
#define PG8_SA(b, h) (((b) * 2 + (h)) * HTB)
#define PG8_SB(b, h) ((4 + (b) * 2 + (h)) * HTB)
#define PG8_STAGE(bufoff, gbase, voff) do { _Pragma("unroll") for (int _i = 0; _i < 2; ++_i) \
        __builtin_amdgcn_global_load_lds((const unsigned*)((const char*)(gbase) + (voff)[_i]), (PG8_LAS unsigned*)(lds + (bufoff) + ldsw + _i * 8192), 16, 0, 0); } while (0)
#define PG8_LDA(dst, b, h) do { _Pragma("unroll") for (int m = 0; m < 4; ++m) _Pragma("unroll") for (int k = 0; k < 2; ++k) dst[m][k] = *(const PG8_LAS bf16x8*)(lds + PG8_SA(b, h) + aoff + m * 2048 + k * 1024); } while (0)
#define PG8_LDB(dst, b, h) do { _Pragma("unroll") for (int n = 0; n < 2; ++n) _Pragma("unroll") for (int k = 0; k < 2; ++k) dst[n][k] = *(const PG8_LAS bf16x8*)(lds + PG8_SB(b, h) + boff + n * 2048 + k * 1024); } while (0)
#define PG8_MMA(ai, bj, At, Bt) do { __builtin_amdgcn_s_setprio(1); _Pragma("unroll") for (int m = 0; m < 4; ++m) _Pragma("unroll") for (int n = 0; n < 2; ++n) _Pragma("unroll") for (int k = 0; k < 2; ++k) \
        acc[ai][bj][m][n] = __builtin_amdgcn_mfma_f32_16x16x32_bf16(Bt[n][k], At[m][k], acc[ai][bj][m][n], 0, 0, 0); __builtin_amdgcn_s_setprio(0); } while (0)
#define PG8_WAIT_V(n) asm volatile("s_waitcnt vmcnt(" #n ")" ::: "memory")
#define PG8_WAIT_L(n) asm volatile("s_waitcnt lgkmcnt(" #n ")" ::: "memory")
#define PG8_BAR __builtin_amdgcn_s_barrier()
#define PG8_SCHED __builtin_amdgcn_sched_barrier(0)
    Unit cur, nxt; int ui = 0;
    if (!S.next(0, cur)) return;
    f32x4 acc[2][2][4][2];
#pragma unroll
    for (int a = 0; a < 2; ++a)
#pragma unroll
        for (int b = 0; b < 2; ++b)
#pragma unroll
            for (int m = 0; m < 4; ++m)
#pragma unroll
                for (int n = 0; n < 2; ++n) acc[a][b][m][n] = (f32x4){0.f, 0.f, 0.f, 0.f};
    bf16x8 At[4][2], B0[2][2], B1[2][2];
    const char* cA = (const char*)g.A + (size_t)cur.pm * tstep; const char* cB = (const char*)g.Bt + (size_t)cur.pn * tstep;
    S.a_ready(cur);
    if constexpr (SP2) {
        PG8_STAGE(PG8_SB(0, 0), cB, voffB); PG8_STAGE(PG8_SB(0, 1), cB + hstep, voffB); PG8_STAGE(PG8_SA(0, 0), cA, voffA); PG8_STAGE(PG8_SA(0, 1), cA + hstep, voffA);
        if (wr == 1) PG8_BAR;
        PG8_WAIT_V(2); PG8_BAR;
        PG8_STAGE(PG8_SB(1, 0), cB + kstep, voffB); PG8_STAGE(PG8_SA(1, 0), cA + kstep, voffA); PG8_STAGE(PG8_SB(1, 1), cB + hstep + kstep, voffB);
        PG8_WAIT_V(6); PG8_BAR;
    } else {
        PG8_STAGE(PG8_SB(0, 0), cB, voffB); PG8_STAGE(PG8_SA(0, 0), cA, voffA); PG8_STAGE(PG8_SB(0, 1), cB + hstep, voffB); PG8_STAGE(PG8_SA(0, 1), cA + hstep, voffA);
        if (wr == 1) PG8_BAR;
        PG8_WAIT_V(4); PG8_BAR;
        PG8_STAGE(PG8_SB(1, 0), cB + kstep, voffB); PG8_STAGE(PG8_SA(1, 0), cA + kstep, voffA); PG8_STAGE(PG8_SB(1, 1), cB + hstep + kstep, voffB);
        PG8_WAIT_V(6); PG8_BAR;
    }
    for (;;) {
        const bool has_next = S.next(ui + 1, nxt);
        const char* nA = has_next ? (const char*)g.A + (size_t)nxt.pm * tstep : cA; const char* nB = has_next ? (const char*)g.Bt + (size_t)nxt.pn * tstep : cB;
        for (int t = 0; t < nt; t += 2) {
            const bool last = (t == nt - 2);
            const char* a1 = cA + (size_t)(t + 1) * kstep;
            const char* a2 = last ? nA : cA + (size_t)(t + 2) * kstep; const char* b2 = last ? nB : cB + (size_t)(t + 2) * kstep;
            const char* a3 = a2 + kstep; const char* b3 = b2 + kstep;
            if (last && has_next) S.a_ready(nxt);
            if constexpr (SP2) {
            PG8_LDB(B0, 0, 0); PG8_LDB(B1, 0, 1); PG8_SCHED; PG8_LDA(At, 0, 0); PG8_STAGE(PG8_SA(1, 1), a1 + hstep, voffA);
            PG8_WAIT_V(8); PG8_WAIT_L(0); PG8_BAR; PG8_MMA(0, 0, At, B0); PG8_MMA(0, 1, At, B1); PG8_BAR; PG8_SCHED;
            PG8_LDA(At, 0, 1); PG8_STAGE(PG8_SB(0, 0), b2, voffB); PG8_STAGE(PG8_SB(0, 1), b2 + hstep, voffB); PG8_STAGE(PG8_SA(0, 0), a2, voffA);
            PG8_WAIT_V(8); PG8_WAIT_L(0); PG8_BAR; PG8_MMA(1, 0, At, B0); PG8_MMA(1, 1, At, B1); PG8_BAR; PG8_SCHED;
            PG8_LDB(B0, 1, 0); PG8_LDB(B1, 1, 1); PG8_SCHED; PG8_LDA(At, 1, 0); PG8_STAGE(PG8_SA(0, 1), a2 + hstep, voffA);
            PG8_WAIT_V(8); PG8_WAIT_L(0); PG8_BAR; PG8_MMA(0, 0, At, B0); PG8_MMA(0, 1, At, B1); PG8_BAR; PG8_SCHED;
            PG8_LDA(At, 1, 1); PG8_STAGE(PG8_SB(1, 0), b3, voffB); PG8_STAGE(PG8_SB(1, 1), b3 + hstep, voffB); PG8_STAGE(PG8_SA(1, 0), a3, voffA);
            PG8_WAIT_V(8); PG8_WAIT_L(0); PG8_BAR; PG8_MMA(1, 0, At, B0); PG8_MMA(1, 1, At, B1); PG8_BAR; PG8_SCHED;
            } else {
            PG8_LDB(B0, 0, 0); PG8_SCHED; PG8_LDA(At, 0, 0); PG8_STAGE(PG8_SA(1, 1), a1 + hstep, voffA);
            PG8_WAIT_L(8); PG8_BAR; PG8_WAIT_L(0); PG8_MMA(0, 0, At, B0); PG8_BAR; PG8_SCHED;
            PG8_LDB(B1, 0, 1); PG8_STAGE(PG8_SB(0, 0), b2, voffB);
            PG8_BAR; PG8_WAIT_L(0); PG8_MMA(0, 1, At, B1); PG8_BAR;
            PG8_LDA(At, 0, 1); PG8_STAGE(PG8_SA(0, 0), a2, voffA);
            PG8_BAR; PG8_WAIT_L(0); PG8_MMA(1, 0, At, B0); PG8_BAR; PG8_SCHED;
            PG8_STAGE(PG8_SB(0, 1), b2 + hstep, voffB);
            PG8_WAIT_V(6); PG8_BAR; PG8_MMA(1, 1, At, B1); PG8_BAR;
            PG8_LDB(B0, 1, 0); PG8_SCHED; PG8_LDA(At, 1, 0); PG8_STAGE(PG8_SA(0, 1), a2 + hstep, voffA);
            PG8_WAIT_L(8); PG8_BAR; PG8_WAIT_L(0); PG8_MMA(0, 0, At, B0); PG8_BAR; PG8_SCHED;
            PG8_LDB(B1, 1, 1); PG8_STAGE(PG8_SB(1, 0), b3, voffB);
            PG8_BAR; PG8_WAIT_L(0); PG8_MMA(0, 1, At, B1); PG8_BAR;
            PG8_LDA(At, 1, 1); PG8_STAGE(PG8_SA(1, 0), a3, voffA);
            PG8_BAR; PG8_WAIT_L(0); PG8_MMA(1, 0, At, B0); PG8_BAR; PG8_SCHED;
            PG8_STAGE(PG8_SB(1, 1), b3 + hstep, voffB);
            PG8_WAIT_V(6); PG8_BAR; PG8_MMA(1, 1, At, B1); PG8_BAR;
            }
        }
        if constexpr (ALIGN_EPI) { if (wr == 0) PG8_BAR; }
        if constexpr (!Epi::AFTER_DRAIN) { E(acc, cur, wr, wc, fr, fq); S.done(cur); }
        if (!has_next) break;
#pragma unroll
        for (int a = 0; a < 2; ++a)
#pragma unroll
            for (int b = 0; b < 2; ++b)
#pragma unroll
                for (int m = 0; m < 4; ++m)
#pragma unroll
                    for (int n = 0; n < 2; ++n) acc[a][b][m][n] = (f32x4){0.f, 0.f, 0.f, 0.f};
        cur = nxt; cA = nA; cB = nB; ++ui;
        if constexpr (ALIGN_EPI) { if (wr == 1) PG8_BAR; }
    }
    PG8_WAIT_V(0);
    if constexpr (!ALIGN_EPI) { if (wr == 0) PG8_BAR; }
    PG8_BAR;
    if constexpr (Epi::AFTER_DRAIN) { E.fused(acc, cur, wr, wc, fr, fq, lds, wid, lane); S.done(cur); }
#undef PG8_SA
#undef PG8_SB
#undef PG8_STAGE
#undef PG8_LDA
#undef PG8_LDB
#undef PG8_MMA
#undef PG8_WAIT_V
#undef PG8_WAIT_L
#undef PG8_BAR
#undef PG8_SCHED
}
template <class Epi, class Sched>
__device__ __forceinline__ void gemm_phase_gather(PG8_LAS unsigned char* lds, const Gemm g, const Sched& S, const Epi& E, const PG8_LAS int* tokl) {
    constexpr bool ALIGN_EPI = true, SP2 = true;
    const int tid = threadIdx.x, wid = __builtin_amdgcn_readfirstlane(tid >> 6), lane = tid & 63, wr = wid >> 2, wc = wid & 3, fr = lane & 15, fq = lane >> 4;
    const int K = g.K, nt = K / BK;
    unsigned voffB[2], cA2[2], v0c[2], v1c[2], v0n[2], v1n[2]; int RA[2];
#pragma unroll
    for (int i = 0; i < 2; ++i) { int R, C; stage_rc(tid * 16 + i * 8192, R, C); const int Rb = Epi::PERM ? ((R & ~31) + perm32(R & 31)) : R;
        RA[i] = R; cA2[i] = (unsigned)C * 2u; voffB[i] = (unsigned)(Rb * K + C) * 2u; }
#define PG8_GOFF(d0, d1, U) do { _Pragma("unroll") for (int _i = 0; _i < 2; ++_i) { d0[_i] = (unsigned)tokl[(U) * 256 + RA[_i]] * (unsigned)(K * 2) + cA2[_i]; d1[_i] = (unsigned)tokl[(U) * 256 + 128 + RA[_i]] * (unsigned)(K * 2) + cA2[_i]; } } while (0)
    const size_t kstep = (size_t)(BK * 2);
    const size_t hstep = (size_t)HALF * K * 2;
    const size_t tstep = 2 * hstep;
    const unsigned ldsw = (unsigned)wid * 1024u;
    const int aoff = lds_byte(wr * 64 + fr, fq * 8), boff = lds_byte(wc * 32 + fr, fq * 8);
#define PG8_SA(b, h) (((b) * 2 + (h)) * HTB)
#define PG8_SB(b, h) ((4 + (b) * 2 + (h)) * HTB)
#define PG8_STAGE(bufoff, gbase, voff) do { _Pragma("unroll") for (int _i = 0; _i < 2; ++_i) \
        __builtin_amdgcn_global_load_lds((const unsigned*)((const char*)(gbase) + (voff)[_i]), (PG8_LAS unsigned*)(lds + (bufoff) + ldsw + _i * 8192), 16, 0, 0); } while (0)
#define PG8_LDA(dst, b, h) do { _Pragma("unroll") for (int m = 0; m < 4; ++m) _Pragma("unroll") for (int k = 0; k < 2; ++k) dst[m][k] = *(const PG8_LAS bf16x8*)(lds + PG8_SA(b, h) + aoff + m * 2048 + k * 1024); } while (0)
#define PG8_LDB(dst, b, h) do { _Pragma("unroll") for (int n = 0; n < 2; ++n) _Pragma("unroll") for (int k = 0; k < 2; ++k) dst[n][k] = *(const PG8_LAS bf16x8*)(lds + PG8_SB(b, h) + boff + n * 2048 + k * 1024); } while (0)
#define PG8_MMA(ai, bj, At, Bt) do { __builtin_amdgcn_s_setprio(1); _Pragma("unroll") for (int m = 0; m < 4; ++m) _Pragma("unroll") for (int n = 0; n < 2; ++n) _Pragma("unroll") for (int k = 0; k < 2; ++k) \
        acc[ai][bj][m][n] = __builtin_amdgcn_mfma_f32_16x16x32_bf16(Bt[n][k], At[m][k], acc[ai][bj][m][n], 0, 0, 0); __builtin_amdgcn_s_setprio(0); } while (0)
#define PG8_WAIT_V(n) asm volatile("s_waitcnt vmcnt(" #n ")" ::: "memory")
#define PG8_WAIT_L(n) asm volatile("s_waitcnt lgkmcnt(" #n ")" ::: "memory")
#define PG8_BAR __builtin_amdgcn_s_barrier()
#define PG8_SCHED __builtin_amdgcn_sched_barrier(0)
    Unit cur, nxt; int ui = 0;
    if (!S.next(0, cur)) return;
    f32x4 acc[2][2][4][2];
#pragma unroll
    for (int a = 0; a < 2; ++a)
#pragma unroll
        for (int b = 0; b < 2; ++b)
#pragma unroll
            for (int m = 0; m < 4; ++m)
#pragma unroll
                for (int n = 0; n < 2; ++n) acc[a][b][m][n] = (f32x4){0.f, 0.f, 0.f, 0.f};
    bf16x8 At[4][2], B0[2][2], B1[2][2];
    const char* const cA = (const char*)g.A; const char* cB = (const char*)g.Bt + (size_t)cur.pn * tstep;
    PG8_GOFF(v0c, v1c, 0);
    S.a_ready(cur);
    {
        PG8_STAGE(PG8_SB(0, 0), cB, voffB); PG8_STAGE(PG8_SB(0, 1), cB + hstep, voffB); PG8_STAGE(PG8_SA(0, 0), cA, v0c); PG8_STAGE(PG8_SA(0, 1), cA, v1c);
        if (wr == 1) PG8_BAR;
        PG8_WAIT_V(2); PG8_BAR;
        PG8_STAGE(PG8_SB(1, 0), cB + kstep, voffB); PG8_STAGE(PG8_SA(1, 0), cA + kstep, v0c); PG8_STAGE(PG8_SB(1, 1), cB + hstep + kstep, voffB);
        PG8_WAIT_V(6); PG8_BAR;
    }
    for (;;) {
        const bool has_next = S.next(ui + 1, nxt);
        const char* nB = has_next ? (const char*)g.Bt + (size_t)nxt.pn * tstep : cB;
        if (has_next) PG8_GOFF(v0n, v1n, ui + 1); else { v0n[0] = v0c[0]; v0n[1] = v0c[1]; v1n[0] = v1c[0]; v1n[1] = v1c[1]; }
        for (int t = 0; t < nt; t += 2) {
            const bool last = (t == nt - 2);
            const char* a1 = cA + (size_t)(t + 1) * kstep;
            const char* a2 = last ? cA : cA + (size_t)(t + 2) * kstep; const char* b2 = last ? nB : cB + (size_t)(t + 2) * kstep;
            const unsigned s0[2] = {last ? v0n[0] : v0c[0], last ? v0n[1] : v0c[1]}, s1[2] = {last ? v1n[0] : v1c[0], last ? v1n[1] : v1c[1]};
            const char* a3 = a2 + kstep; const char* b3 = b2 + kstep;
            if (last && has_next) S.a_ready(nxt);
            if constexpr (SP2) {
            PG8_LDB(B0, 0, 0); PG8_LDB(B1, 0, 1); PG8_SCHED; PG8_LDA(At, 0, 0); PG8_STAGE(PG8_SA(1, 1), a1, v1c);
            PG8_WAIT_V(8); PG8_WAIT_L(0); PG8_BAR; PG8_MMA(0, 0, At, B0); PG8_MMA(0, 1, At, B1); PG8_BAR; PG8_SCHED;
            PG8_LDA(At, 0, 1); PG8_STAGE(PG8_SB(0, 0), b2, voffB); PG8_STAGE(PG8_SB(0, 1), b2 + hstep, voffB); PG8_STAGE(PG8_SA(0, 0), a2, s0);
            PG8_WAIT_V(8); PG8_WAIT_L(0); PG8_BAR; PG8_MMA(1, 0, At, B0); PG8_MMA(1, 1, At, B1); PG8_BAR; PG8_SCHED;
            PG8_LDB(B0, 1, 0); PG8_LDB(B1, 1, 1); PG8_SCHED; PG8_LDA(At, 1, 0); PG8_STAGE(PG8_SA(0, 1), a2, s1);
            PG8_WAIT_V(8); PG8_WAIT_L(0); PG8_BAR; PG8_MMA(0, 0, At, B0); PG8_MMA(0, 1, At, B1); PG8_BAR; PG8_SCHED;
            PG8_LDA(At, 1, 1); PG8_STAGE(PG8_SB(1, 0), b3, voffB); PG8_STAGE(PG8_SB(1, 1), b3 + hstep, voffB); PG8_STAGE(PG8_SA(1, 0), a3, s0);
            PG8_WAIT_V(8); PG8_WAIT_L(0); PG8_BAR; PG8_MMA(1, 0, At, B0); PG8_MMA(1, 1, At, B1); PG8_BAR; PG8_SCHED;
            }
        }
        if constexpr (ALIGN_EPI) { if (wr == 0) PG8_BAR; }
        if constexpr (!Epi::AFTER_DRAIN) { E(acc, cur, wr, wc, fr, fq); S.done(cur); }
        if (!has_next) break;
#pragma unroll
        for (int a = 0; a < 2; ++a)
#pragma unroll
            for (int b = 0; b < 2; ++b)
#pragma unroll
                for (int m = 0; m < 4; ++m)
#pragma unroll
                    for (int n = 0; n < 2; ++n) acc[a][b][m][n] = (f32x4){0.f, 0.f, 0.f, 0.f};
        cur = nxt; cB = nB; ++ui; v0c[0] = v0n[0]; v0c[1] = v0n[1]; v1c[0] = v1n[0]; v1c[1] = v1n[1];
        if constexpr (ALIGN_EPI) { if (wr == 1) PG8_BAR; }
    }
    PG8_WAIT_V(0);
    if constexpr (!ALIGN_EPI) { if (wr == 0) PG8_BAR; }
    PG8_BAR;
    if constexpr (Epi::AFTER_DRAIN) { E.fused(acc, cur, wr, wc, fr, fq, lds, wid, lane); S.done(cur); }
#undef PG8_GOFF
#undef PG8_SA
#undef PG8_SB
#undef PG8_STAGE
#undef PG8_LDA
#undef PG8_LDB
#undef PG8_MMA
#undef PG8_WAIT_V
#undef PG8_WAIT_L
#undef PG8_BAR
#undef PG8_SCHED
}
}

constexpr int NWAVES = 8, NTHREADS = 512;
constexpr int BATCH = 2, SEQ = 8192, NTOK = BATCH * SEQ, DM = 1024, INC = 4096;
constexpr int NE = 32, TOPK = 4;
constexpr int PMAX = NTOK * TOPK + NE * 256;
constexpr int MAXTILES = PMAX / 256;
constexpr float EPS = 1e-6f;
constexpr int C_HQ = 0, C_HFF = 512, C_HFB = 1024, C_HI = 1536, C_HG = 2048, C_AQ = 2560, C_AK = 3072, C_AV = 3584;

#ifndef MK_PER_PHASE
#define MK_PER_PHASE 0
#endif
constexpr int NPHASE = 12;

constexpr size_t MiB = 1u << 20;
constexpr size_t WS_CTL = 0, CTL_ZERO_BYTES = 1 * MiB;
constexpr size_t WS_WIN = 2 * MiB, WS_WOUT = 10 * MiB, WS_WUP = 12 * MiB, WS_WDN = 140 * MiB;
constexpr size_t WS_XN = 204 * MiB, WS_PROJ = 236 * MiB, WS_CS = 364 * MiB, WS_QR = 368 * MiB, WS_KR = 384 * MiB;
constexpr size_t WS_MIX = 400 * MiB, WS_OF = 432 * MiB, WS_RT = 496 * MiB, WS_XS = 498 * MiB, WS_ACT = 642 * MiB, WS_END = 786 * MiB;
constexpr size_t RT_TOPE = 0, RT_TOPG = 256 * 1024, RT_SLOT = 512 * 1024, RT_HIST = 768 * 1024, RT_GATE = 1024 * 1024, RT_TOK = 1536 * 1024, RT_LBS = 1900 * 1024;
constexpr int CW_TMO = 0, CW_BAR = 4096;

constexpr int RING_BYTES = 131072;
constexpr int LDSCTL_OFF = RING_BYTES;
constexpr int MISC_OFF = LDSCTL_OFF;
constexpr int L_HIST = LDSCTL_OFF + 256;
constexpr int L_TOT = L_HIST + 128;
constexpr int L_MINE = L_TOT + 128;
constexpr int L_PADS = L_MINE + 128;
constexpr int L_TEXP = L_PADS + 256;
constexpr int L_ITE = L_TEXP + 512;
constexpr int L_ITP = L_ITE + 1024;
constexpr int L_HG = L_ITP + 1024;
constexpr int LDS_BYTES = 147456;
static_assert(L_HG + 12288 <= LDS_BYTES, "LDS map");

#define GAS __attribute__((address_space(1)))
#define LAS __attribute__((address_space(3)))
typedef unsigned short bf16;
typedef unsigned v4u __attribute__((ext_vector_type(4)));
typedef unsigned v2u __attribute__((ext_vector_type(2)));
typedef float f32x4 __attribute__((ext_vector_type(4)));
typedef GAS unsigned gu32;
#define RLX_AGENT __ATOMIC_RELAXED, __HIP_MEMORY_SCOPE_AGENT
#define LDS_WAIT() asm volatile("s_waitcnt lgkmcnt(0)" ::: "memory")
#define VM_WAIT() asm volatile("s_waitcnt vmcnt(0)" ::: "memory")
__device__ __forceinline__ unsigned f2bf(float f) { unsigned u = __builtin_bit_cast(unsigned, f); return (u + 0x7fffu + ((u >> 16) & 1u)) >> 16; }
__device__ __forceinline__ unsigned pk2(float lo, float hi) { return f2bf(lo) | (f2bf(hi) << 16); }
__device__ __forceinline__ float bf2f(unsigned b) { return __builtin_bit_cast(float, b << 16); }
__device__ __forceinline__ float bflo(unsigned w) { return __builtin_bit_cast(float, w << 16); }
__device__ __forceinline__ float bfhi(unsigned w) { return __builtin_bit_cast(float, w & 0xffff0000u); }
__device__ __forceinline__ float sigm(float x) { return __builtin_amdgcn_rcpf(1.0f + __builtin_amdgcn_exp2f(-1.4426950408889634f * x)); }

#define XB_TMO      128
#define XB_XCNT(j)  (256  + 64 * (j))
#define XB_XSUB(j)  (1280 + 64 * (j))
#define XB_XGEN(j)  (2304 + 64 * (j))
#define XB_TOP      3328
#define XB_TOPGEN   3392
#define XCD_BAR_WORDS 3456
#define XB_SPIN_CAP (1u << 23)
__device__ __forceinline__ unsigned xb_ld(unsigned* p)              { return __hip_atomic_load(p, __ATOMIC_RELAXED, __HIP_MEMORY_SCOPE_AGENT); }
__device__ __forceinline__ unsigned xb_add(unsigned* p, unsigned v) { return __hip_atomic_fetch_add(p, v, __ATOMIC_RELAXED, __HIP_MEMORY_SCOPE_AGENT); }
__device__ __forceinline__ unsigned xb_xcc_id() { return (unsigned)__builtin_amdgcn_s_getreg((3 << 11) | 20) & 0xFu; }
#define XB_SPIN(cond, bar) do { unsigned _sp = 0; while (cond) { __builtin_amdgcn_s_sleep(1); \
    if ((++_sp & 255u) == 0u) { if (xb_ld(&(bar)[XB_TMO])) break; if (_sp > XB_SPIN_CAP) { atomicAdd(&(bar)[XB_TMO], 1u); break; } } } } while (0)
struct XcdBarrier { unsigned* bar; unsigned x; volatile LAS unsigned* st; };
__device__ __forceinline__ XcdBarrier xcd_barrier_post(unsigned* bar, volatile LAS unsigned* st) {
    XcdBarrier b; b.bar = bar; b.x = xb_xcc_id(); b.st = st;
    if (threadIdx.x == 0) (void)xb_add(&bar[XB_XCNT(b.x)], 1u);
    return b;
}
__device__ __forceinline__ void xcd_barrier_complete(unsigned* bar, unsigned x, unsigned& nloc, unsigned& nx) {
    const unsigned G = gridDim.x * gridDim.y * gridDim.z;
    unsigned sum, cnt, mine, sp = 0u;
    for (;;) {
        sum = 0u; cnt = 0u; mine = 0u;
#pragma unroll
        for (unsigned j = 0; j < 16; ++j) { const unsigned c = xb_ld(&bar[XB_XCNT(j)]); sum += c; cnt += (c > 0u) ? 1u : 0u; mine = (j == x) ? c : mine; }
        if (sum == G) break;
        __builtin_amdgcn_s_sleep(1);
        if ((++sp & 255u) == 0u) { if (xb_ld(&bar[XB_TMO])) break; if (sp > XB_SPIN_CAP) { atomicAdd(&bar[XB_TMO], 1u); break; } }
    }
    nloc = mine > 0u ? mine : 1u; nx = cnt > 0u ? cnt : 1u;
}
__device__ __forceinline__ void xcd_barrier(const XcdBarrier& b) {
    asm volatile("s_waitcnt vmcnt(0)" ::: "memory");
    __syncthreads();
    if (threadIdx.x == 0) {
        unsigned* bar = b.bar;
        __builtin_amdgcn_s_waitcnt(0);
        unsigned nloc = b.st[0], nx = b.st[1];
        if (nloc == 0u) { xcd_barrier_complete(bar, b.x, nloc, nx); b.st[0] = nloc; b.st[1] = nx; }
        const unsigned old = xb_add(&bar[XB_XSUB(b.x)], 1u);
        const unsigned gen = old / nloc;
        if (old + 1u == (gen + 1u) * nloc) {
            __builtin_amdgcn_fence(__ATOMIC_RELEASE, "agent");
            asm volatile("s_waitcnt vmcnt(0)" ::: "memory");
            const unsigned og = xb_add(&bar[XB_TOP], 1u);
            const unsigned tg = og / nx;
            if (og + 1u == (tg + 1u) * nx) xb_add(&bar[XB_TOPGEN], 1u);
            else XB_SPIN(xb_ld(&bar[XB_TOPGEN]) == tg, bar);
            __builtin_amdgcn_fence(__ATOMIC_ACQUIRE, "agent");
            xb_add(&bar[XB_XGEN(b.x)], 1u);
            asm volatile("s_waitcnt vmcnt(0)" ::: "memory");
        } else {
            XB_SPIN(xb_ld(&bar[XB_XGEN(b.x)]) == gen, bar);
            __builtin_amdgcn_fence(__ATOMIC_ACQUIRE, "agent");
            asm volatile("s_waitcnt vmcnt(0)" ::: "memory");
        }
    }
    __syncthreads();
}

__device__ __forceinline__ float wave_sum(float v) {
#pragma unroll
    for (int o = 1; o < 64; o <<= 1) v += __shfl_xor(v, o);
    return v;
}

struct Args {
    const float* x; const int* pos; const float* g1; const float* w_in; const float* qg; const float* kg; const float* lb; const float* og;
    const float* w_out; const float* g2; const float* w_r; const float* b_r; const float* w_up; const float* b_up; const float* w_dn; const float* b_dn;
    float* out; unsigned char* ws; int ph_lo, ph_hi;
};

struct P0Item { const float* src; bf16* dst; int N; int sh; };
__device__ __forceinline__ P0Item p0_decode(const Args& a, int it) {
    constexpr int I_UP = NE * 32 * 32, I_DN = NE * 32 * 16, I_IN = 32 * 64;
    bf16* Win_t = (bf16*)(a.ws + WS_WIN); bf16* Wout_t = (bf16*)(a.ws + WS_WOUT); bf16* Wup_t = (bf16*)(a.ws + WS_WUP); bf16* Wdn_t = (bf16*)(a.ws + WS_WDN);
    P0Item I; int r = it; I.sh = 0;
    if (r < I_UP) { const int e = r >> 10, kb = (r >> 5) & 31, jb = r & 31, j0 = 32 * jb, c0 = 256 * (j0 >> 7) + (j0 & 127);
        I.sh = 1; I.N = 2048; I.src = a.w_up + ((size_t)e * 1024 + kb * 32) * 2048 + 64 * jb; I.dst = Wup_t + ((size_t)e * 2048 + c0) * 1024 + kb * 32; return I; }
    r -= I_UP;
    if (r < I_DN) { const int e = r >> 9, kb = (r >> 4) & 31, nb = r & 15;
        I.N = 1024; I.src = a.w_dn + ((size_t)e * 1024 + kb * 32) * 1024 + nb * 64; I.dst = Wdn_t + ((size_t)e * 1024 + nb * 64) * 1024 + kb * 32; return I; }
    r -= I_DN;
    if (r < I_IN) { const int kb = r >> 6, nb = r & 63; I.N = INC; I.src = a.w_in + (size_t)(kb * 32) * INC + nb * 64; I.dst = Win_t + (size_t)(nb * 64) * 1024 + kb * 32; return I; }
    r -= I_IN;
    { const int kb = r >> 4, nb = r & 15; I.N = 1024; I.src = a.w_out + (size_t)(kb * 32) * 1024 + nb * 64; I.dst = Wout_t + (size_t)(nb * 64) * 1024 + kb * 32; return I; }
}
#define P0_LOAD(IT) do { const P0Item I_ = p0_decode(a, (IT)); const float* sp_ = I_.src + (size_t)(lane >> 4) * I_.N + 4 * (lane & 15); \
        _Pragma("unroll") for (int i = 0; i < 8; ++i) rr[i] = __builtin_nontemporal_load((const f32x4*)(sp_ + (size_t)(4 * i) * I_.N)); } while (0)
__device__ __forceinline__ void p0_prologue(const Args& a, LAS unsigned char* lds, int gw, int NGW, int lane, int wave) {
    LAS float* scr = (LAS float*)(lds + wave * 16384);
    constexpr int NITEMS = NE * 32 * 32 + NE * 32 * 16 + 32 * 64 + 32 * 16;
    f32x4 rr[8];
    if (gw < NITEMS) P0_LOAD(gw);
    for (int it = gw; it < NITEMS; it += NGW) {
        const P0Item I = p0_decode(a, it);
#pragma unroll
        for (int i = 0; i < 8; ++i) { LAS float* wp = scr + (4 * i + (lane >> 4)) * 65 + 4 * (lane & 15); wp[0] = rr[i].x; wp[1] = rr[i].y; wp[2] = rr[i].z; wp[3] = rr[i].w; }
        LDS_WAIT(); asm volatile("" ::: "memory");
        if (it + NGW < NITEMS) P0_LOAD(it + NGW);
        const int c = lane & 3;
#pragma unroll
        for (int j = 0; j < 4; ++j) { const int n = (lane >> 2) + 16 * j; const LAS float* sp = scr + (8 * c) * 65 + n;
            v4u o; o.x = pk2(sp[0 * 65], sp[1 * 65]); o.y = pk2(sp[2 * 65], sp[3 * 65]); o.z = pk2(sp[4 * 65], sp[5 * 65]); o.w = pk2(sp[6 * 65], sp[7 * 65]);
            __builtin_nontemporal_store(o, (GAS v4u*)(I.dst + (size_t)((n >> I.sh) + 128 * (n & I.sh)) * 1024 + 8 * c)); }
        LDS_WAIT(); asm volatile("" ::: "memory");
    }
    bf16* XN = (bf16*)(a.ws + WS_XN);
    f32x4 g[4];
#pragma unroll
    for (int j = 0; j < 4; ++j) g[j] = ((const f32x4*)a.g1)[64 * j + lane];
    for (int m = gw; m < NTOK; m += NGW) {
        const f32x4* xr = (const f32x4*)(a.x + (size_t)m * DM) + lane;
        f32x4 v[4]; float s = 0.f;
#pragma unroll
        for (int j = 0; j < 4; ++j) { v[j] = xr[64 * j]; s += (v[j].x * v[j].x + v[j].y * v[j].y) + (v[j].z * v[j].z + v[j].w * v[j].w); }
        const float rstd = __builtin_amdgcn_rsqf(wave_sum(s) * (1.0f / DM) + EPS);
        v2u* o8 = (v2u*)(XN + (size_t)m * DM) + lane;
#pragma unroll
        for (int j = 0; j < 4; ++j) { v2u w; w.x = pk2(v[j].x * rstd * g[j].x, v[j].y * rstd * g[j].y); w.y = pk2(v[j].z * rstd * g[j].z, v[j].w * rstd * g[j].w); o8[64 * j] = w; }
    }
    { const int gi = gw * 64 + lane; if (gi < 1024) ((float*)(a.ws + WS_RT + RT_LBS))[gi] = 1.0f / (1.0f + expf(a.lb[1024 + gi] - a.lb[gi])); }
    float* CS = (float*)(a.ws + WS_CS);
    for (int idx = gw * 64 + lane; idx < NTOK * 32; idx += NGW * 64) {
        const int tok = idx >> 5, i = idx & 31;
        const float inv = exp2f(-(float)i * 0.41524101186092029f);
        const float ang = (float)a.pos[tok] * inv;
        double r = (double)ang * 0.15915494309189535; r -= floor(r);
        const float rf = (float)r;
        CS[(size_t)tok * 64 + i] = __builtin_amdgcn_cosf(rf); CS[(size_t)tok * 64 + 32 + i] = __builtin_amdgcn_sinf(rf);
    }
}

__device__ __forceinline__ void p2_qkprep(const Args& a, int gw, int NGW, int lane) {
    const bf16* PROJ = (const bf16*)(a.ws + WS_PROJ); const float* CS = (const float*)(a.ws + WS_CS);
    const int c = lane & 7, ci = (c & 3) * 8;
    const f32x4 gq0 = *(const f32x4*)(a.qg + 8 * c), gq1 = *(const f32x4*)(a.qg + 8 * c + 4), gk0 = *(const f32x4*)(a.kg + 8 * c), gk1 = *(const f32x4*)(a.kg + 8 * c + 4);
    for (int tok = gw; tok < NTOK; tok += NGW) {
        const v4u wq = *(const v4u*)(PROJ + (size_t)tok * INC + C_AQ + lane * 8), wk = *(const v4u*)(PROJ + (size_t)tok * INC + C_AK + lane * 8);
        const f32x4 c0 = *(const f32x4*)(CS + (size_t)tok * 64 + ci), c1 = *(const f32x4*)(CS + (size_t)tok * 64 + ci + 4), s0 = *(const f32x4*)(CS + (size_t)tok * 64 + 32 + ci), s1 = *(const f32x4*)(CS + (size_t)tok * 64 + 32 + ci + 4);
        const float cs_[8] = {c0.x, c0.y, c0.z, c0.w, c1.x, c1.y, c1.z, c1.w}, sn_[8] = {s0.x, s0.y, s0.z, s0.w, s1.x, s1.y, s1.z, s1.w};
#pragma unroll
        for (int isk = 0; isk < 2; ++isk) {
            const v4u w = isk ? wk : wq; const f32x4 g0 = isk ? gk0 : gq0, g1 = isk ? gk1 : gq1;
            float x[8] = {bflo(w.x), bfhi(w.x), bflo(w.y), bfhi(w.y), bflo(w.z), bfhi(w.z), bflo(w.w), bfhi(w.w)};
            const float gg[8] = {g0.x, g0.y, g0.z, g0.w, g1.x, g1.y, g1.z, g1.w};
            float ss = 0.f;
#pragma unroll
            for (int j = 0; j < 8; ++j) ss += x[j] * x[j];
            ss += __shfl_xor(ss, 1); ss += __shfl_xor(ss, 2); ss += __shfl_xor(ss, 4);
            const float rstd = __builtin_amdgcn_rsqf(ss * (1.0f / 64.0f) + EPS) * (isk ? 1.0f : 0.125f * 1.4426950408889634f);
            float o[8];
#pragma unroll
            for (int j = 0; j < 8; ++j) { const float y = x[j] * rstd * gg[j]; const float yp = __shfl_xor(y, 4);
                o[j] = (c < 4) ? (y * cs_[j] - yp * sn_[j]) : (y * cs_[j] + yp * sn_[j]); }
            v4u ow; ow.x = pk2(o[0], o[1]); ow.y = pk2(o[2], o[3]); ow.z = pk2(o[4], o[5]); ow.w = pk2(o[6], o[7]);
            *(v4u*)((bf16*)(a.ws + (isk ? WS_KR : WS_QR)) + (size_t)tok * 512 + lane * 8) = ow;
        }
    }
}

#define RT_LOADPAIR(V0, V1, R0) do { const f32x4* x0_ = (const f32x4*)(a.out + (size_t)(R0) * DM) + lane; \
        _Pragma("unroll") for (int j = 0; j < 4; ++j) { V0[j] = x0_[64 * j]; V1[j] = x0_[64 * j + DM / 4]; } } while (0)
template <int LEVEL> __device__ __forceinline__ void rt_tree(float& o0, float& o1, const f32x4 (&v0)[4], const f32x4 (&v1)[4], const LAS float* W, int lane) {
    if constexpr (LEVEL == 0) { float p0 = 0.f, p1 = 0.f;
#pragma unroll
        for (int j = 0; j < 4; ++j) { const f32x4 w = *(const LAS f32x4*)(W + 256 * j + 4 * lane);
            p0 += (v0[j].x * w.x + v0[j].y * w.y) + (v0[j].z * w.z + v0[j].w * w.w); p1 += (v1[j].x * w.x + v1[j].y * w.y) + (v1[j].z * w.z + v1[j].w * w.w); }
        o0 = p0; o1 = p1;
    } else { constexpr int msk = 1 << (LEVEL - 1); float a0, a1, b0, b1;
        rt_tree<LEVEL - 1>(a0, a1, v0, v1, W, lane); rt_tree<LEVEL - 1>(b0, b1, v0, v1, W + msk * 1024, lane);
        const bool up = (lane & msk) != 0;
        o0 = (up ? b0 : a0) + __shfl_xor(up ? a0 : b0, msk); o1 = (up ? b1 : a1) + __shfl_xor(up ? a1 : b1, msk); }
}
__device__ __forceinline__ void rt_finish_row(float part, float br, int lane, int row, int* tope, float* topg, LAS int* lhist) {
    const float logit = part + __shfl_xor(part, 32) + br;
    const int myi = lane & 31; float tv[4]; int ti[4]; float cur = logit;
#pragma unroll
    for (int k = 0; k < 4; ++k) { float bv = cur; int bi = myi;
#pragma unroll
        for (int o = 1; o < 32; o <<= 1) { const float ov = __shfl_xor(bv, o); const int oi = __shfl_xor(bi, o); if (ov > bv || (ov == bv && oi < bi)) { bv = ov; bi = oi; } }
        tv[k] = bv; ti[k] = bi; if (myi == bi) cur = -3.0e38f; }
    const float e1 = __expf(tv[1] - tv[0]), e2 = __expf(tv[2] - tv[0]), e3 = __expf(tv[3] - tv[0]); const float inv = __builtin_amdgcn_rcpf(1.0f + e1 + e2 + e3);
    if (lane < 4) { const int ee = lane == 0 ? ti[0] : lane == 1 ? ti[1] : lane == 2 ? ti[2] : ti[3]; const float gg = (lane == 0 ? 1.0f : lane == 1 ? e1 : lane == 2 ? e2 : e3) * inv;
        tope[row * 4 + lane] = ee; topg[row * 4 + lane] = gg; __hip_atomic_fetch_add(&lhist[ee], 1, __ATOMIC_RELAXED, __HIP_MEMORY_SCOPE_WORKGROUP); }
}
__device__ __forceinline__ void p6_router(const Args& a, LAS unsigned char* lds, int tid, int lane, int wave) {
    LAS float* WrT = (LAS float*)lds;
    LAS int* lhist = (LAS int*)(lds + L_HIST);
    bf16* XN = (bf16*)(a.ws + WS_XN);
    int* tope = (int*)(a.ws + WS_RT + RT_TOPE); float* topg = (float*)(a.ws + WS_RT + RT_TOPG); int* hist = (int*)(a.ws + WS_RT + RT_HIST);
    const int blk0 = (int)blockIdx.x;
    f32x4 va[4], vb[4];
    if (blk0 < NTOK / 64) RT_LOADPAIR(va, vb, blk0 * 64 + wave * 8);
#pragma unroll
    for (int j = 0; j < 16; ++j) { const int e4 = j >> 1, k = tid + 512 * (j & 1); const f32x4 w = *(const f32x4*)(a.w_r + (size_t)k * 32 + 4 * e4);
        WrT[(4 * e4 + 0) * 1024 + k] = w.x; WrT[(4 * e4 + 1) * 1024 + k] = w.y; WrT[(4 * e4 + 2) * 1024 + k] = w.z; WrT[(4 * e4 + 3) * 1024 + k] = w.w; }
    if (tid < 32) lhist[tid] = 0;
    __syncthreads();
    f32x4 g[4];
#pragma unroll
    for (int j = 0; j < 4; ++j) g[j] = ((const f32x4*)a.g2)[64 * j + lane];
    const float br = a.b_r[lane & 31];
    for (int blk = blk0; blk < NTOK / 64; blk += (int)gridDim.x) {
#pragma unroll 1
        for (int pr = 0; pr < 4; ++pr) {
            const int row = blk * 64 + wave * 8 + 2 * pr;
            f32x4 v0[4], v1[4];
#pragma unroll
            for (int j = 0; j < 4; ++j) { v0[j] = va[j]; v1[j] = vb[j]; }
            { const int nrow = (pr < 3) ? row + 2 : ((blk + (int)gridDim.x < NTOK / 64) ? (blk + (int)gridDim.x) * 64 + wave * 8 : row); RT_LOADPAIR(va, vb, nrow); }
            float s0 = 0.f, s1 = 0.f;
#pragma unroll
            for (int j = 0; j < 4; ++j) { s0 += (v0[j].x * v0[j].x + v0[j].y * v0[j].y) + (v0[j].z * v0[j].z + v0[j].w * v0[j].w); s1 += (v1[j].x * v1[j].x + v1[j].y * v1[j].y) + (v1[j].z * v1[j].z + v1[j].w * v1[j].w); }
            const float r0 = __builtin_amdgcn_rsqf(wave_sum(s0) * (1.0f / DM) + EPS), r1 = __builtin_amdgcn_rsqf(wave_sum(s1) * (1.0f / DM) + EPS);
            v2u* o0 = (v2u*)(XN + (size_t)row * DM) + lane; v2u* o1 = (v2u*)(XN + (size_t)(row + 1) * DM) + lane;
#pragma unroll
            for (int j = 0; j < 4; ++j) { v0[j] = v0[j] * r0 * g[j]; v1[j] = v1[j] * r1 * g[j];
                v2u w; w.x = pk2(v0[j].x, v0[j].y); w.y = pk2(v0[j].z, v0[j].w); o0[64 * j] = w; w.x = pk2(v1[j].x, v1[j].y); w.y = pk2(v1[j].z, v1[j].w); o1[64 * j] = w; }
            float q0, q1; rt_tree<5>(q0, q1, v0, v1, WrT, lane);
            rt_finish_row(q0, br, lane, row, tope, topg, lhist);
            rt_finish_row(q1, br, lane, row + 1, tope, topg, lhist);
        }
        __syncthreads();
        if (tid < 32) { hist[blk * 32 + tid] = lhist[tid]; lhist[tid] = 0; }
        __syncthreads();
    }
}
#undef RT_LOADPAIR

__device__ __forceinline__ void moe_tables(const Args& a, LAS unsigned char* lds, int tid, int blk) {
    const int* hist = (const int*)(a.ws + WS_RT + RT_HIST);
    LAS int* tot = (LAS int*)(lds + L_TOT); LAS int* mine = (LAS int*)(lds + L_MINE); LAS int* pads = (LAS int*)(lds + L_PADS); LAS unsigned char* texp = (LAS unsigned char*)(lds + L_TEXP);
    LAS int* part = (LAS int*)lds;
    { const int e = tid & 31, pt = tid >> 5; int t = 0, m = 0;
#pragma unroll
      for (int q = 0; q < 16; ++q) { const int b2 = pt * 16 + q; const int hv = hist[b2 * 32 + e]; t += hv; m += (b2 < blk) ? hv : 0; }
      part[pt * 32 + e] = t; part[512 + pt * 32 + e] = m; }
    __syncthreads();
    if (tid < 32) { int t = 0, m = 0;
#pragma unroll
      for (int q = 0; q < 16; ++q) { t += part[q * 32 + tid]; m += part[512 + q * 32 + tid]; }
      tot[tid] = t; mine[tid] = m;
      const int tl = (t + 255) >> 8; int x = tl;
#pragma unroll
      for (int o = 1; o < 32; o <<= 1) { const int y = __shfl_up(x, o); if (tid >= o) x += y; }
      const int excl = x - tl; pads[tid] = excl * 256;
      for (int q = 0; q < tl; ++q) texp[excl + q] = (unsigned char)tid;
      if (tid == 31) pads[32] = x; }
    __syncthreads();
}

__device__ __forceinline__ void p7_gather(const Args& a, LAS unsigned char* lds, int tid, int lane, int wave) {
    const int* tope = (const int*)(a.ws + WS_RT + RT_TOPE); const float* topg = (const float*)(a.ws + WS_RT + RT_TOPG);
    int* slot = (int*)(a.ws + WS_RT + RT_SLOT); float* rgate = (float*)(a.ws + WS_RT + RT_GATE); int* rtok = (int*)(a.ws + WS_RT + RT_TOK);
    LAS int* mine = (LAS int*)(lds + L_MINE); LAS int* pads = (LAS int*)(lds + L_PADS); LAS int* ite = (LAS int*)(lds + L_ITE); LAS int* itp = (LAS int*)(lds + L_ITP);
    for (int blk = (int)blockIdx.x; blk < NTOK / 64; blk += (int)gridDim.x) {
        moe_tables(a, lds, tid, blk);
        if (tid < 256) ite[tid] = tope[blk * 256 + tid];
        __syncthreads();
        if (tid < 256) { const int me = ite[tid]; int cnt = 0;
#pragma unroll 8
            for (int j4 = 0; j4 < 64; ++j4) { const v4u w = *(const LAS v4u*)(ite + 4 * j4); const int jb = 4 * j4;
                cnt += ((int)w.x == me && jb < tid) + ((int)w.y == me && jb + 1 < tid) + ((int)w.z == me && jb + 2 < tid) + ((int)w.w == me && jb + 3 < tid); }
            itp[tid] = pads[me] + mine[me] + cnt; }
        if (tid < 256) { const int p = itp[tid]; slot[blk * 256 + tid] = p; rgate[p] = topg[blk * 256 + tid]; rtok[p] = blk * 64 + (tid >> 2); }
        if (blk < 32) { LAS int* tot = (LAS int*)(lds + L_TOT); const int beg = pads[blk] + tot[blk], end = pads[blk] + ((tot[blk] + 255) & ~255); if (beg + tid < end) rtok[beg + tid] = 0; }
        __syncthreads();
    }
}

__device__ __forceinline__ void p10_combine(const Args& a, int gw, int NGW, int lane) {
    const int* slot = (const int*)(a.ws + WS_RT + RT_SLOT); const bf16* Y = (const bf16*)(a.ws + WS_XS);
    for (int tok = gw; tok < NTOK; tok += NGW) {
        const int r0 = slot[tok * 4], r1 = slot[tok * 4 + 1], r2 = slot[tok * 4 + 2], r3 = slot[tok * 4 + 3];
        f32x4* o = (f32x4*)(a.out + (size_t)tok * DM) + lane;
#pragma unroll
        for (int j = 0; j < 4; ++j) { f32x4 v = o[64 * j];
            const v2u y0 = ((const v2u*)(Y + (size_t)r0 * DM))[64 * j + lane], y1 = ((const v2u*)(Y + (size_t)r1 * DM))[64 * j + lane], y2 = ((const v2u*)(Y + (size_t)r2 * DM))[64 * j + lane], y3 = ((const v2u*)(Y + (size_t)r3 * DM))[64 * j + lane];
            v.x += (bflo(y0.x) + bflo(y1.x)) + (bflo(y2.x) + bflo(y3.x)); v.y += (bfhi(y0.x) + bfhi(y1.x)) + (bfhi(y2.x) + bfhi(y3.x));
            v.z += (bflo(y0.y) + bflo(y1.y)) + (bflo(y2.y) + bflo(y3.y)); v.w += (bfhi(y0.y) + bfhi(y1.y)) + (bfhi(y2.y) + bfhi(y3.y));
            o[64 * j] = v; }
    }
}


typedef float f32x16 __attribute__((ext_vector_type(16)));
typedef short bf16x8 __attribute__((ext_vector_type(8)));
typedef short s16x4 __attribute__((ext_vector_type(4)));
typedef float f32x2_t __attribute__((ext_vector_type(2)));
typedef __bf16 bf16x2_t __attribute__((ext_vector_type(2)));
__device__ __forceinline__ int crow(int r, int hi) { return (r & 3) + 8 * (r >> 2) + 4 * hi; }
__device__ __forceinline__ unsigned cvtpk(float lo, float hi) { f32x2_t v = {lo, hi}; bf16x2_t b = __builtin_convertvector(v, bf16x2_t); return __builtin_bit_cast(unsigned, b); }
__device__ __forceinline__ s16x4 vtr(const LAS unsigned char* p) { return __builtin_bit_cast(s16x4, __builtin_amdgcn_ds_read_tr16_b64_v4i16((LAS s16x4*)p)); }
#define VFRAG(lo, hi) (bf16x8){lo[0], lo[1], lo[2], lo[3], hi[0], hi[1], hi[2], hi[3]}
__device__ __forceinline__ bf16x8 pfrag(const f32x16& s, int b) { v4u w; w.x = cvtpk(s[b], s[b + 1]); w.y = cvtpk(s[b + 2], s[b + 3]); w.z = cvtpk(s[b + 4], s[b + 5]); w.w = cvtpk(s[b + 6], s[b + 7]); return __builtin_bit_cast(bf16x8, w); }

constexpr size_t WS_US = 432 * MiB;
constexpr size_t WS_OP = 786 * MiB;
constexpr size_t WS_AD = 834 * MiB;
constexpr size_t WS_LP = 835 * MiB;
constexpr size_t WS_END2 = 838 * MiB;

__device__ __forceinline__ void attn_unit(const Args& a, LAS unsigned char* wl, int wu, int lane, float Bl2) {
    const bf16* PROJ = (const bf16*)(a.ws + WS_PROJ); const bf16* QR = (const bf16*)(a.ws + WS_QR); const bf16* KR = (const bf16*)(a.ws + WS_KR);
    const int tile = wu & 255, r_ = wu >> 8, p = r_ % 3, bh = r_ / 3, b = bh >> 3, h = bh & 7;
    const int dsh = 2 * p, dil = 1 << dsh, tpr = 256 >> dsh, r = tile >> (8 - dsh), l0 = (tile & (tpr - 1)) * 32, L = SEQ >> dsh;
    const int r32 = lane & 31, hi = lane >> 5;
    const size_t tb = (size_t)b * SEQ + r;
    bf16x8 qf[4];
    { const bf16* qp = QR + (tb + (size_t)(l0 + r32) * dil) * 512 + h * 64 + hi * 8;
#pragma unroll
      for (int d0 = 0; d0 < 4; ++d0) qf[d0] = *(const bf16x8*)(qp + d0 * 16); }
    f32x16 o0, o1;
#pragma unroll
    for (int i = 0; i < 16; ++i) { o0[i] = 0.f; o1[i] = 0.f; }
    float lsum = 0.f;
    const LAS unsigned char* vb = wl + (4 * hi + ((lane & 15) >> 2)) * 64 + ((lane >> 4) & 1) * 32 + (lane & 3) * 8;
    bf16x8 kf[2][4]; v4u vv[2][4];
#define ATT_LOAD(KT, BUF) do { const int kb_ = l0 - 64 + 32 * (KT); int lk_ = kb_ + r32; lk_ = lk_ < 0 ? 0 : (lk_ >= L ? L - 1 : lk_); \
        const bf16* kp_ = KR + (tb + (size_t)lk_ * dil) * 512 + h * 64 + hi * 8; \
        _Pragma("unroll") for (int d0 = 0; d0 < 4; ++d0) kf[BUF][d0] = *(const bf16x8*)(kp_ + d0 * 16); \
        _Pragma("unroll") for (int i = 0; i < 4; ++i) { int lv_ = kb_ + 8 * i + (lane >> 3); lv_ = lv_ < 0 ? 0 : (lv_ >= L ? L - 1 : lv_); \
            vv[BUF][i] = *(const v4u*)(PROJ + (tb + (size_t)lv_ * dil) * INC + C_AV + h * 64 + (lane & 7) * 8); } } while (0)
    ATT_LOAD(0, 0);
#pragma unroll
    for (int kt = 0; kt < 5; ++kt) {
        if (kt < 4) ATT_LOAD(kt + 1, (kt + 1) & 1);
        const int kb = l0 - 64 + 32 * kt;
        if (!(kb + 31 < 0 || kb >= L)) {
#pragma unroll
        for (int i = 0; i < 4; ++i) { const int kr = 8 * i + (lane >> 3), c = lane & 7; *(LAS v4u*)(wl + (c >> 2) * 2048 + (kr >> 3) * 512 + (kr & 7) * 64 + (c & 3) * 16) = vv[kt & 1][i]; }
        f32x16 s;
#pragma unroll
        for (int i = 0; i < 16; ++i) s[i] = 0.f;
#pragma unroll
        for (int d0 = 0; d0 < 4; ++d0) s = __builtin_amdgcn_mfma_f32_32x32x16_bf16(kf[kt & 1][d0], qf[d0], s, 0, 0, 0);
#pragma unroll
        for (int rg = 0; rg < 16; ++rg) { const int key = kb + crow(rg, hi), dq = key - (l0 + r32);
            const bool ok = (dq >= -64) && (dq <= 64) && (key >= 0) && (key < L);
            const float pe = ok ? __builtin_amdgcn_exp2f(s[rg] - Bl2) : 0.f; lsum += pe; s[rg] = pe; }
        const bf16x8 pw0 = pfrag(s, 0), pw1 = pfrag(s, 8);
        { const s16x4 a0 = vtr(vb), a1 = vtr(vb + 512), b0 = vtr(vb + 1024), b1 = vtr(vb + 1536);
          o0 = __builtin_amdgcn_mfma_f32_32x32x16_bf16(pw0, VFRAG(a0, a1), o0, 0, 0, 0); o0 = __builtin_amdgcn_mfma_f32_32x32x16_bf16(pw1, VFRAG(b0, b1), o0, 0, 0, 0); }
        { const s16x4 a0 = vtr(vb + 2048), a1 = vtr(vb + 2048 + 512), b0 = vtr(vb + 2048 + 1024), b1 = vtr(vb + 2048 + 1536);
          o1 = __builtin_amdgcn_mfma_f32_32x32x16_bf16(pw0, VFRAG(a0, a1), o1, 0, 0, 0); o1 = __builtin_amdgcn_mfma_f32_32x32x16_bf16(pw1, VFRAG(b0, b1), o1, 0, 0, 0); }
        }
    }
#undef ATT_LOAD
    lsum += __shfl_xor(lsum, 32);
    float* LP = (float*)(a.ws + WS_LP) + (size_t)p * NTOK * 8;
    if (hi == 0) LP[(tb + (size_t)(l0 + r32) * dil) * 8 + h] = lsum;
    LAS bf16* stg = (LAS bf16*)wl;
#pragma unroll
    for (int rg = 0; rg < 16; ++rg) { const int orow = crow(rg, hi); stg[orow * 64 + r32] = (bf16)f2bf(o0[rg]); stg[orow * 64 + 32 + r32] = (bf16)f2bf(o1[rg]); }
    bf16* OP = (bf16*)(a.ws + WS_OP) + (size_t)p * NTOK * 512;
#pragma unroll
    for (int i = 0; i < 4; ++i) { const int row = 8 * i + (lane >> 3), ch = lane & 7; const v4u v = *(const LAS v4u*)(wl + row * 128 + ch * 16);
        *(v4u*)(OP + (tb + (size_t)(l0 + row) * dil) * 512 + h * 64 + ch * 8) = v; }
}
__device__ __forceinline__ float attn_bound_l2(const Args& a, int lane) {
    float mq = fabsf(a.qg[lane]), mk = fabsf(a.kg[lane]);
#pragma unroll
    for (int o = 1; o < 64; o <<= 1) { mq = fmaxf(mq, __shfl_xor(mq, o)); mk = fmaxf(mk, __shfl_xor(mk, o)); }
    return 8.0f * mq * mk * 1.4426950408889634f + 0.5f;
}
__device__ __forceinline__ void p3_attn(const Args& a, LAS unsigned char* lds, int lane, int wave) {
    const float Bl2 = attn_bound_l2(a, lane);
    LAS unsigned char* wl = lds + 98304 + wave * 4096;
    for (int bu = (int)blockIdx.x; bu < BATCH * 8 * 3 * 256 / 8; bu += (int)gridDim.x) attn_unit(a, wl, bu * 8 + wave, lane, Bl2);
}

__device__ __forceinline__ int vt_off(int row, int col) { return (col >> 5) * 4096 + (row >> 3) * 512 + (row & 7) * 64 + (col & 31) * 2; }
__device__ __forceinline__ int sw_off(int row, int col) { return row * 272 + col * 2; }
constexpr int H_V = 0, H_TOT = 16384, H_ZF = 18432, H_ZB = 35840, H_QR = 53248, H_QTF = 70656, H_QTB = 88064, H_KUT = 53248;
struct HgTiles { v4u zf[2], zb[2], v[2], q[2], hg[2]; };
template <bool FULL> __device__ __forceinline__ void hg_issue(const bf16* PROJ, int item, int tid, HgTiles& T) {
    const int bh = item >> 7, n = item & 127, b = bh >> 2, h = bh & 3; const size_t t0 = (size_t)b * SEQ + 64 * n;
#pragma unroll
    for (int i = 0; i < 2; ++i) { const int idx = tid + 512 * i, row = idx >> 4, ch = idx & 15; const bf16* rp = PROJ + (t0 + row) * INC + h * 128 + ch * 8;
        T.zf[i] = *(const v4u*)(rp + C_HFF); T.zb[i] = *(const v4u*)(rp + C_HFB); T.v[i] = *(const v4u*)(rp + C_HI); if (FULL) T.q[i] = *(const v4u*)(rp + C_HQ); }
    if (FULL) { const int row = tid >> 3, seg = tid & 7; const bf16* rp = PROJ + (t0 + row) * INC + C_HG + h * 128 + 16 * seg; T.hg[0] = *(const v4u*)rp; T.hg[1] = *(const v4u*)(rp + 8); }
}
template <bool FULL> __device__ __forceinline__ void hg_write(LAS unsigned char* lds, int tid, const HgTiles& T) {
#pragma unroll
    for (int i = 0; i < 2; ++i) { const int idx = tid + 512 * i, row = idx >> 4, ch = idx & 15; const int so = sw_off(row, ch * 8);
        *(LAS v4u*)(lds + H_ZF + so) = T.zf[i]; *(LAS v4u*)(lds + H_ZB + so) = T.zb[i]; *(LAS v4u*)(lds + H_V + vt_off(row, ch * 8)) = T.v[i]; if (FULL) *(LAS v4u*)(lds + H_QR + so) = T.q[i]; }
}
#define HG_PASS1() \
    const int dir = tid >> 8, half = (tid >> 7) & 1, d = tid & 127; \
    LAS float* tot = (LAS float*)(lds + H_TOT); \
    float g[32]; \
    { const LAS unsigned char* zt = lds + (dir ? H_ZB : H_ZF); float tsum = 0.f; \
      _Pragma("unroll") for (int i = 0; i < 32; ++i) { g[i] = bf2f(*(const LAS bf16*)(zt + sw_off(half * 32 + i, d))); tsum += g[i]; } \
      tot[(dir * 2 + half) * 128 + d] = tsum; } \
    __syncthreads(); \
    const float tother = tot[(dir * 2 + (half ^ 1)) * 128 + d];
#define HG_K(G) (1.0f - __builtin_amdgcn_exp2f(1.4426950408889634f * (G)))

__device__ __forceinline__ void hg_summary_phase(const Args& a, LAS unsigned char* lds, int tid, int lane, int wave) {
    const bf16* PROJ = (const bf16*)(a.ws + WS_PROJ);
    const int G = gridDim.x; int item = blockIdx.x; if (item >= 1024) return;
    HgTiles T; hg_issue<false>(PROJ, item, tid, T);
    for (; item < 1024; item += G) {
        const int bh = item >> 7, n = item & 127, b = bh >> 2, h = bh & 3;
        hg_write<false>(lds, tid, T);
        __syncthreads();
        if (item + G < 1024) hg_issue<false>(PROJ, item + G, tid, T);
        LAS unsigned char* kut = lds + H_KUT;
        HG_PASS1();
        { unsigned pk[16];
          if (dir == 0) { float run = half ? 0.f : tother;
#pragma unroll
              for (int i = 31; i >= 0; --i) { const float v = HG_K(g[i]) * __expf(run); run += g[i]; if (i & 1) pk[i >> 1] = f2bf(v) << 16; else pk[i >> 1] |= f2bf(v); } }
          else { float run = half ? tother : 0.f;
#pragma unroll
              for (int i = 0; i < 32; ++i) { const float v = HG_K(g[i]) * __expf(run); run += g[i]; if (i & 1) pk[i >> 1] |= f2bf(v) << 16; else pk[i >> 1] = f2bf(v); } }
          LAS unsigned char* rowp = kut + (dir * 128 + d) * 144 + half * 64;
#pragma unroll
          for (int j = 0; j < 4; ++j) { v4u w; w.x = pk[4 * j]; w.y = pk[4 * j + 1]; w.z = pk[4 * j + 2]; w.w = pk[4 * j + 3]; *(LAS v4u*)(rowp + 16 * j) = w; }
          if (half == 0) ((float*)(a.ws + WS_AD))[(((size_t)dir * 8 + bh) * 128 + n) * 128 + d] = __expf(tother + tot[(dir * 2) * 128 + d]);
        }
        __syncthreads();
        { const int wdir = wave >> 2, rt = wave & 3, r32 = lane & 31, hi = lane >> 5;
          bf16x8 af[4];
#pragma unroll
          for (int ks = 0; ks < 4; ++ks) af[ks] = *(const LAS bf16x8*)(kut + (wdir * 128 + 32 * rt + r32) * 144 + (16 * ks + 8 * hi) * 2);
          bf16* UT = (bf16*)(a.ws + WS_US) + ((((size_t)wdir * 8 + bh) * 128 + n) << 14);
          const int q = (lane & 15) >> 2, pp = lane & 3, g1 = (lane >> 4) & 1;
#pragma unroll
          for (int ct = 0; ct < 4; ++ct) { f32x16 acc;
#pragma unroll
              for (int i = 0; i < 16; ++i) acc[i] = 0.f;
#pragma unroll
              for (int ks = 0; ks < 4; ++ks) { const int row = 16 * ks + 8 * hi + q, col = 32 * ct + 16 * g1 + 4 * pp;
                  const s16x4 lo = vtr(lds + H_V + vt_off(row, col)), hh = vtr(lds + H_V + vt_off(row + 4, col));
                  acc = __builtin_amdgcn_mfma_f32_32x32x16_bf16(af[ks], VFRAG(lo, hh), acc, 0, 0, 0); }
              bf16* up = UT + (size_t)(32 * ct + r32) * 128 + 32 * rt + 4 * hi;
#pragma unroll
              for (int q4 = 0; q4 < 4; ++q4) { v2u w; w.x = cvtpk(acc[4 * q4], acc[4 * q4 + 1]); w.y = cvtpk(acc[4 * q4 + 2], acc[4 * q4 + 3]); *(v2u*)(up + 8 * q4) = w; } }
        }
        __syncthreads();
    }
}
__device__ __forceinline__ void hg_scan(const Args& a, int gtid, int NGT) {
    for (int idx = gtid; idx < 16 * 8192; idx += NGT) {
        const int chain = idx >> 13, e2 = idx & 8191, dk = (2 * e2) & 127, dir = chain >> 3;
        unsigned* U = (unsigned*)(a.ws + WS_US) + ((size_t)chain * 128 << 13) + e2;
        const float* AD = (const float*)(a.ws + WS_AD) + (size_t)chain * 128 * 128 + dk;
        float r0 = 0.f, r1 = 0.f;
#pragma unroll 8
        for (int st = 0; st < 128; ++st) { const int n = dir ? 127 - st : st;
            const unsigned u = U[(size_t)n << 13]; const f32x2_t av = *(const f32x2_t*)(AD + n * 128);
            U[(size_t)n << 13] = pk2(r0, r1);
            r0 = av.x * r0 + bflo(u); r1 = av.y * r1 + bfhi(u); }
    }
}
__device__ __forceinline__ void hg_output_phase(const Args& a, LAS unsigned char* lds, int tid, int lane, int wave) {
    const bf16* PROJ = (const bf16*)(a.ws + WS_PROJ);
    const int G = gridDim.x; int item = blockIdx.x; if (item >= 1024) return;
    HgTiles T; hg_issue<true>(PROJ, item, tid, T);
    const int ct = wave & 1, dvt = wave >> 1, r32 = lane & 31, hi = lane >> 5;
    for (; item < 1024; item += G) {
        const int bh = item >> 7, n = item & 127, b = bh >> 2, h = bh & 3; const size_t t0 = (size_t)b * SEQ + 64 * n;
        hg_write<true>(lds, tid, T);
        const v4u hg0 = T.hg[0], hg1 = T.hg[1];
        __syncthreads();
        if (item + G < 1024) hg_issue<true>(PROJ, item + G, tid, T);
        bf16x8 sf0[8], sf1[8];
        const bf16* ST0 = (const bf16*)(a.ws + WS_US) + ((((size_t)0 * 8 + bh) * 128 + n) << 14) + (size_t)(32 * dvt + r32) * 128 + 8 * hi;
        const bf16* ST1 = ST0 + ((size_t)8 * 128 << 14);
#pragma unroll
        for (int kd = 0; kd < 8; ++kd) sf0[kd] = *(const bf16x8*)(ST0 + 16 * kd);
        HG_PASS1();
        { LAS unsigned char* qt = lds + (dir ? H_QTB : H_QTF); LAS unsigned char* kt = lds + (dir ? H_ZB : H_ZF); const LAS unsigned char* qr_ = lds + H_QR;
          if (dir == 0) { float run = half ? tother : 0.f;
#pragma unroll
              for (int i = 0; i < 32; ++i) { run += g[i]; const int c = half * 32 + i, so = sw_off(c, d); const float qv = bf2f(*(const LAS bf16*)(qr_ + so));
                  *(LAS bf16*)(qt + so) = (bf16)f2bf(qv * __expf(run)); *(LAS bf16*)(kt + so) = (bf16)f2bf(HG_K(g[i]) * __expf(-run)); } }
          else { float run = half ? 0.f : tother;
#pragma unroll
              for (int i = 31; i >= 0; --i) { run += g[i]; const int c = half * 32 + i, so = sw_off(c, d); const float qv = bf2f(*(const LAS bf16*)(qr_ + so));
                  *(LAS bf16*)(qt + so) = (bf16)f2bf(qv * __expf(run)); *(LAS bf16*)(kt + so) = (bf16)f2bf(HG_K(g[i]) * __expf(-run)); } }
        }
        __syncthreads();
        f32x16 o;
#pragma unroll
        for (int i = 0; i < 16; ++i) o[i] = 0.f;
#pragma unroll
        for (int kd = 0; kd < 8; ++kd) sf1[kd] = *(const bf16x8*)(ST1 + 16 * kd);
        { const int q = (lane & 15) >> 2, pp = lane & 3, g1 = (lane >> 4) & 1;
#pragma unroll
          for (int dr = 0; dr < 2; ++dr) {
              const LAS unsigned char* qt = lds + (dr ? H_QTB : H_QTF); const LAS unsigned char* kt = lds + (dr ? H_ZB : H_ZF);
              bf16x8 qf[8];
#pragma unroll
              for (int kd = 0; kd < 8; ++kd) qf[kd] = *(const LAS bf16x8*)(qt + sw_off(32 * ct + r32, 16 * kd + 8 * hi));
#pragma unroll
              for (int st = 0; st < 2; ++st) {
                  if (dr == 0 ? (st > ct) : (st < ct)) continue;
                  f32x16 x;
#pragma unroll
                  for (int i = 0; i < 16; ++i) x[i] = 0.f;
#pragma unroll
                  for (int kd = 0; kd < 8; ++kd) { const bf16x8 kf = *(const LAS bf16x8*)(kt + sw_off(32 * st + r32, 16 * kd + 8 * hi)); x = __builtin_amdgcn_mfma_f32_32x32x16_bf16(kf, qf[kd], x, 0, 0, 0); }
                  if (st == ct) {
#pragma unroll
                      for (int rg = 0; rg < 16; ++rg) { const int s_ = crow(rg, hi); const bool keep = dr == 0 ? (s_ <= r32) : (s_ >= r32); x[rg] = keep ? x[rg] : 0.f; } }
                  const bf16x8 pw0 = pfrag(x, 0), pw1 = pfrag(x, 8);
                  const int col = 32 * dvt + 16 * g1 + 4 * pp;
                  { const int row = 32 * st + 4 * hi + q; const s16x4 lo = vtr(lds + H_V + vt_off(row, col)), hh = vtr(lds + H_V + vt_off(row + 8, col));
                    o = __builtin_amdgcn_mfma_f32_32x32x16_bf16(pw0, VFRAG(lo, hh), o, 0, 0, 0); }
                  { const int row = 32 * st + 16 + 4 * hi + q; const s16x4 lo = vtr(lds + H_V + vt_off(row, col)), hh = vtr(lds + H_V + vt_off(row + 8, col));
                    o = __builtin_amdgcn_mfma_f32_32x32x16_bf16(pw1, VFRAG(lo, hh), o, 0, 0, 0); }
              }
#pragma unroll
              for (int kd = 0; kd < 8; ++kd) o = __builtin_amdgcn_mfma_f32_32x32x16_bf16(qf[kd], dr ? sf1[kd] : sf0[kd], o, 0, 0, 0);
          } }
        __syncthreads();
        LAS float* stg = (LAS float*)(lds + H_QTF);
#pragma unroll
        for (int rg = 0; rg < 16; ++rg) stg[(32 * ct + crow(rg, hi)) * 132 + 32 * dvt + r32] = o[rg];
        __syncthreads();
        { const int row = tid >> 3, seg = tid & 7; const LAS float* sp = stg + row * 132 + 16 * seg; float v[16]; float ss = 0.f;
#pragma unroll
          for (int j = 0; j < 4; ++j) { const f32x4 w = *(const LAS f32x4*)(sp + 4 * j); v[4 * j] = w.x; v[4 * j + 1] = w.y; v[4 * j + 2] = w.z; v[4 * j + 3] = w.w; ss += (w.x * w.x + w.y * w.y) + (w.z * w.z + w.w * w.w); }
          ss += __shfl_xor(ss, 1); ss += __shfl_xor(ss, 2); ss += __shfl_xor(ss, 4);
          const float rstd = __builtin_amdgcn_rsqf(ss * (1.0f / 128.0f) + EPS);
          const float hg[16] = {bflo(hg0.x), bfhi(hg0.x), bflo(hg0.y), bfhi(hg0.y), bflo(hg0.z), bfhi(hg0.z), bflo(hg0.w), bfhi(hg0.w), bflo(hg1.x), bfhi(hg1.x), bflo(hg1.y), bfhi(hg1.y), bflo(hg1.z), bfhi(hg1.z), bflo(hg1.w), bfhi(hg1.w)};
          float r[16];
#pragma unroll
          for (int j = 0; j < 16; ++j) r[j] = v[j] * rstd * a.og[16 * seg + j] * hg[j];
          v4u w0, w1; w0.x = pk2(r[0], r[1]); w0.y = pk2(r[2], r[3]); w0.z = pk2(r[4], r[5]); w0.w = pk2(r[6], r[7]); w1.x = pk2(r[8], r[9]); w1.y = pk2(r[10], r[11]); w1.z = pk2(r[12], r[13]); w1.w = pk2(r[14], r[15]);
          bf16* mp = (bf16*)(a.ws + WS_MIX) + (t0 + row) * 1024 + h * 128 + 16 * seg; *(v4u*)mp = w0; *(v4u*)(mp + 8) = w1; }
    }
}
__device__ __forceinline__ void attn_merge(const Args& a, int gw, int NGW, int lane) {
    const bf16* OP = (const bf16*)(a.ws + WS_OP); const float* LP = (const float*)(a.ws + WS_LP); bf16* MIX = (bf16*)(a.ws + WS_MIX);
    for (int tok = gw; tok < NTOK; tok += NGW) {
        float acc[8] = {0.f, 0.f, 0.f, 0.f, 0.f, 0.f, 0.f, 0.f}; float l = 0.f;
#pragma unroll
        for (int p = 0; p < 3; ++p) { const v4u w = *(const v4u*)(OP + ((size_t)p * NTOK + tok) * 512 + lane * 8); l += LP[((size_t)p * NTOK + tok) * 8 + (lane >> 3)];
            acc[0] += bflo(w.x); acc[1] += bfhi(w.x); acc[2] += bflo(w.y); acc[3] += bfhi(w.y); acc[4] += bflo(w.z); acc[5] += bfhi(w.z); acc[6] += bflo(w.w); acc[7] += bfhi(w.w); }
        const float il = 1.0f / l; v4u w; w.x = pk2(acc[0] * il, acc[1] * il); w.y = pk2(acc[2] * il, acc[3] * il); w.z = pk2(acc[4] * il, acc[5] * il); w.w = pk2(acc[6] * il, acc[7] * il);
        *(v4u*)(MIX + (size_t)tok * 1024 + 512 + lane * 8) = w;
    }
}

__global__ void __launch_bounds__(NTHREADS, 2) mk_fwd(Args a) {
    extern __shared__ __attribute__((aligned(16))) unsigned char lds_raw[];
    LAS unsigned char* lds = (LAS unsigned char*)lds_raw;
    const int tid = threadIdx.x, lane = tid & 63, wave = __builtin_amdgcn_readfirstlane(tid >> 6);
    const int G = gridDim.x, bx = blockIdx.x;
    const int vcu = (G % 8 == 0) ? (bx % 8) * (G / 8) + bx / 8 : bx;
    const int gw = vcu * NWAVES + wave, NGW = G * NWAVES, gtid = bx * NTHREADS + tid, NGT = G * NTHREADS;
    unsigned* ctl = (unsigned*)(a.ws + WS_CTL);
    for (int u = tid; u < (LDS_BYTES - LDSCTL_OFF) / 4; u += NTHREADS) ((LAS unsigned*)(lds + LDSCTL_OFF))[u] = 0u;
    __syncthreads();
    XcdBarrier bar; bar.bar = ctl + CW_BAR; bar.x = 0; bar.st = nullptr;
    if (!MK_PER_PHASE) bar = xcd_barrier_post(ctl + CW_BAR, (volatile LAS unsigned*)(lds + MISC_OFF) + 8);
    const int lo = a.ph_lo, hi = a.ph_hi;
#ifndef PH_MASK
#define PH_MASK 0xfff
#endif
#define IN(k) (((PH_MASK >> (k)) & 1) && lo <= (k) && (k) < hi)
#ifndef PROBE_PH
#define PROBE_PH -1
#endif
#define REP(k) for (int _r = 0; _r < ((PROBE_PH == (k)) ? 2 : 1); ++_r)
#ifndef TIME_PH
#define TIME_PH -1
#endif
    unsigned long long t_beg = 0, t_end = 0;
#define STAMP(k) do { if (TIME_PH >= 0 && bx == 0 && tid == 0) { const unsigned long long t_ = __builtin_amdgcn_s_memrealtime(); if ((k) == TIME_PH) t_beg = t_; if ((k) == TIME_PH + 1) t_end = t_; } } while (0)
#define SEAM(k) do { if (IN(k) && IN((k) + 1)) xcd_barrier(bar); STAMP((k) + 1); } while (0)
    STAMP(0);

    if (IN(0)) REP(0) { p0_prologue(a, lds, gw, NGW, lane, wave); } SEAM(0);
    if (IN(1)) REP(1) {
        pg8::Gemm g{(const pg8::bf16_t*)(a.ws + WS_XN), (const pg8::bf16_t*)(a.ws + WS_WIN), NTOK, INC, DM}; pg8::StaticOrder S; S.init(NTOK, INC, G, bx);
        pg8::EpiProj E{(pg8::bf16_t*)(a.ws + WS_PROJ), (const float*)(a.ws + WS_RT + RT_LBS)};
        pg8::gemm_phase<pg8::EpiProj, pg8::StaticOrder, true, true>(lds, g, S, E);
    } SEAM(1);
    if (IN(2)) REP(2) { p2_qkprep(a, gw, NGW, lane); } SEAM(2);
    if (IN(3)) REP(3) { p3_attn(a, lds, lane, wave);
        hg_summary_phase(a, lds, tid, lane, wave);
    } SEAM(3);
    if (IN(4)) REP(4) {
        hg_scan(a, gtid, NGT);
    } SEAM(4);
    if (IN(5)) REP(5) {
        hg_output_phase(a, lds, tid, lane, wave);
        attn_merge(a, gw, NGW, lane);
    } SEAM(5);
    if (IN(6)) REP(6) {
        pg8::Gemm g{(const pg8::bf16_t*)(a.ws + WS_MIX), (const pg8::bf16_t*)(a.ws + WS_WOUT), NTOK, DM, DM}; pg8::StaticOrder S; S.init(NTOK, DM, G, bx);
        pg8::EpiResF32 E{a.x, a.out, DM};
        pg8::gemm_phase<pg8::EpiResF32, pg8::StaticOrder, true, true>(lds, g, S, E);
    } SEAM(6);
    if (IN(7)) REP(7) { p6_router(a, lds, tid, lane, wave); } SEAM(7);
    if (IN(8)) REP(8) { p7_gather(a, lds, tid, lane, wave); } SEAM(8);
    if (IN(9)) REP(9) {
        if (lo == 9) moe_tables(a, lds, tid, 0);
        const int ntiles = ((LAS int*)(lds + L_PADS))[32];
        pg8::Gemm g{(const pg8::bf16_t*)(a.ws + WS_XN), (const pg8::bf16_t*)(a.ws + WS_WUP), NTOK, 2048, DM};
        pg8::MoeOrder S{8, ntiles * 8, G, bx, (const LAS unsigned char*)(lds + L_TEXP)};
        pg8::EpiSwiglu E{(pg8::bf16_t*)(a.ws + WS_ACT), a.b_up};
        LAS int* tokl = (LAS int*)(lds + L_HG); const int* rtok = (const int*)(a.ws + WS_RT + RT_TOK);
        { pg8::Unit u; for (int ui = 0; ui < 12 && S.next(ui, u); ++ui) if (tid < 256) tokl[ui * 256 + tid] = rtok[u.pm * 256 + tid]; }
        __syncthreads();
        pg8::gemm_phase_gather<pg8::EpiSwiglu, pg8::MoeOrder>(lds, g, S, E, tokl);
    } SEAM(9);
    if (IN(10)) REP(10) {
        if (lo == 10) moe_tables(a, lds, tid, 0);
        const int ntiles = ((LAS int*)(lds + L_PADS))[32];
        pg8::Gemm g{(const pg8::bf16_t*)(a.ws + WS_ACT), (const pg8::bf16_t*)(a.ws + WS_WDN), PMAX, 1024, DM};
        pg8::MoeOrder S{4, ntiles * 4, G, bx, (const LAS unsigned char*)(lds + L_TEXP)};
        pg8::EpiDown E{(pg8::bf16_t*)(a.ws + WS_XS), a.b_dn, (const float*)(a.ws + WS_RT + RT_GATE)};
        pg8::gemm_phase<pg8::EpiDown, pg8::MoeOrder, true, true>(lds, g, S, E);
    } SEAM(10);
    if (IN(11)) REP(11) { p10_combine(a, gw, NGW, lane); }
    if (TIME_PH >= 0 && bx == 0 && tid == 0) { asm volatile("s_waitcnt vmcnt(0)" ::: "memory"); STAMP(12); const unsigned long long dt = (t_end - t_beg) * 8ull, t0_ = __builtin_amdgcn_s_memrealtime();
        while (__builtin_amdgcn_s_memrealtime() - t0_ < dt) __builtin_amdgcn_s_sleep(8); }
#undef IN
#undef SEAM
}

extern "C" void kernel_launch(void* const* d_in, const int* in_sizes, int n_in, void* d_out, int out_size, void* d_ws, size_t ws_size, hipStream_t stream) {
    static int grid = 0;
    if (grid == 0) {
        if (n_in != 16 || in_sizes[0] != NTOK * DM || out_size != NTOK * DM || ws_size < WS_END2) { fprintf(stderr, "kernel_launch: unexpected shapes / workspace (%d inputs, ws %zu)\n", n_in, ws_size); grid = -1; return; }
        int dev = 0, cus = 0;
        if (hipGetDevice(&dev) != hipSuccess || hipDeviceGetAttribute(&cus, hipDeviceAttributeMultiprocessorCount, dev) != hipSuccess) { grid = -1; return; }
        if (hipFuncSetAttribute((const void*)mk_fwd, hipFuncAttributeMaxDynamicSharedMemorySize, LDS_BYTES) != hipSuccess) { fprintf(stderr, "kernel_launch: hipFuncSetAttribute failed\n"); grid = -1; return; }
        (void)hipGetLastError();
        grid = cus;
    }
    if (grid < 0) return;
    if (hipMemsetAsync((char*)d_ws + WS_CTL, 0, CTL_ZERO_BYTES, stream) != hipSuccess) return;
    Args a{};
    a.x = (const float*)d_in[0]; a.pos = (const int*)d_in[1]; a.g1 = (const float*)d_in[2]; a.w_in = (const float*)d_in[3]; a.qg = (const float*)d_in[4]; a.kg = (const float*)d_in[5];
    a.lb = (const float*)d_in[6]; a.og = (const float*)d_in[7]; a.w_out = (const float*)d_in[8]; a.g2 = (const float*)d_in[9]; a.w_r = (const float*)d_in[10]; a.b_r = (const float*)d_in[11];
    a.w_up = (const float*)d_in[12]; a.b_up = (const float*)d_in[13]; a.w_dn = (const float*)d_in[14]; a.b_dn = (const float*)d_in[15];
    a.out = (float*)d_out; a.ws = (unsigned char*)d_ws;
#if MK_PER_PHASE
    for (int p = 0; p < NPHASE; ++p) { a.ph_lo = p; a.ph_hi = p + 1;
        hipLaunchKernelGGL(mk_fwd, dim3(grid), dim3(NTHREADS), LDS_BYTES, stream, a);
    }
#else
    a.ph_lo = 0; a.ph_hi = NPHASE; hipLaunchKernelGGL(mk_fwd, dim3(grid), dim3(NTHREADS), LDS_BYTES, stream, a);
#endif
}
```
